# Optimizing an MI355X kernel written in HIP

```python
import math
import jax, jax.numpy as jnp
from jax import lax
import numpy as np

D_MODEL = 1024
BATCH = 4
SEQ = 8192
DEPTH = 1

D_LRU = D_MODEL
LRU_BLOCKS = 16
LRU_BW = D_LRU // LRU_BLOCKS
CONV_W = 4
LRU_C = 8.0
N_HEADS = 8
HEAD_DIM = 128
D_ATTN = N_HEADS * HEAD_DIM
BLOCK_Q = 128
D_FF = 4 * D_MODEL
N_BRANCH = 2
RMS_EPS = 1e-6
IN_SPLITS = (D_LRU, D_LRU, D_ATTN, D_ATTN, D_ATTN, N_BRANCH * D_MODEL, N_HEADS)
D_IN = sum(IN_SPLITS)

kernel_name = "hybrid_rglru_fox_gated_block"


def rms_norm(x, g):
    xf = x.astype(jnp.float32)
    y = xf * lax.rsqrt(jnp.mean(xf * xf, axis=-1, keepdims=True) + RMS_EPS)
    return (y * g.astype(jnp.float32)).astype(x.dtype)


def causal_depthwise_conv(x, w, b):
    S = x.shape[1]
    xp = jnp.pad(x, ((0, 0), (CONV_W - 1, 0), (0, 0)))
    out = b
    for k in range(CONV_W):
        out = out + xp[:, k:k + S, :] * w[k]
    return out


def block_diag_linear(x, w, b):
    B, S, _ = x.shape
    xb = x.reshape(B, S, LRU_BLOCKS, LRU_BW)
    y = jnp.einsum('bsnc,ncd->bsnd', xb, w).reshape(B, S, D_LRU)
    return y + b


def rg_lru(x, wa, ba, wx, bx, lam):
    r = jax.nn.sigmoid(block_diag_linear(x, wa, ba).astype(jnp.float32))
    i = jax.nn.sigmoid(block_diag_linear(x, wx, bx).astype(jnp.float32))
    log_a = -LRU_C * r * jax.nn.softplus(-lam.astype(jnp.float32))
    a = jnp.exp(log_a)
    mult = jnp.sqrt(-jnp.expm1(2.0 * log_a))
    bterm = mult * (i * x.astype(jnp.float32))

    def combine(left, right):
        a1, b1 = left
        a2, b2 = right
        return a1 * a2, a2 * b1 + b2

    _, h = lax.associative_scan(combine, (a, bterm), axis=1)
    return h.astype(x.dtype)


def fox_attention(q, k, v, log_f):
    S = q.shape[1]
    scale = 1.0 / math.sqrt(HEAD_DIM)
    F = jnp.cumsum(log_f.astype(jnp.float32), axis=1)
    F = jnp.transpose(F, (0, 2, 1))
    outs = []
    for blk in range(S // BLOCK_Q):
        q0, q1 = blk * BLOCK_Q, (blk + 1) * BLOCK_Q
        qb = q[:, q0:q1]
        kb = k[:, :q1]
        vb = v[:, :q1]
        s = jnp.einsum('bqhd,bkhd->bhqk', qb, kb).astype(jnp.float32) * scale
        s = s + F[:, :, q0:q1, None] - F[:, :, None, :q1]
        q_pos = jnp.arange(q0, q1)
        k_pos = jnp.arange(q1)
        mask = q_pos[:, None] >= k_pos[None, :]
        s = jnp.where(mask[None, None], s, -jnp.inf)
        p = jax.nn.softmax(s, axis=-1).astype(v.dtype)
        outs.append(jnp.einsum('bhqk,bkhd->bqhd', p, vb))
    return jnp.concatenate(outs, axis=1)


def setup_inputs(seed: int = 0) -> dict:
    key = jax.random.key(seed)
    ks = jax.random.split(key, 20)
    f32 = jnp.float32
    n = lambda k, shape, s: jax.random.normal(k, shape, f32) * s
    x = jax.random.normal(ks[0], (BATCH, SEQ, D_MODEL), f32)
    norm_mix_g = 1.0 + n(ks[1], (D_MODEL,), 0.02)
    w_in = n(ks[2], (D_MODEL, D_IN), D_MODEL ** -0.5)
    conv_w = n(ks[3], (CONV_W, D_LRU), CONV_W ** -0.5)
    conv_b = n(ks[4], (D_LRU,), 0.02)
    lru_wa = n(ks[5], (LRU_BLOCKS, LRU_BW, LRU_BW), LRU_BW ** -0.5)
    lru_ba = n(ks[6], (D_LRU,), 0.02)
    lru_wx = n(ks[7], (LRU_BLOCKS, LRU_BW, LRU_BW), LRU_BW ** -0.5)
    lru_bx = n(ks[8], (D_LRU,), 0.02)
    a0 = jax.random.uniform(ks[9], (D_LRU,), f32, 0.9, 0.999)
    s0 = a0 ** (1.0 / LRU_C)
    lru_lambda = jnp.log(s0) - jnp.log1p(-s0)
    forget_b = 2.0 + n(ks[10], (N_HEADS,), 0.5)
    w_branch_a = n(ks[11], (D_LRU, D_MODEL), D_LRU ** -0.5)
    w_branch_b = n(ks[12], (D_ATTN, D_MODEL), D_ATTN ** -0.5)
    w_out = n(ks[13], (D_MODEL, D_MODEL), D_MODEL ** -0.5)
    norm_mlp_g = 1.0 + n(ks[14], (D_MODEL,), 0.02)
    w_up = n(ks[15], (D_MODEL, D_FF), D_MODEL ** -0.5)
    w_down = n(ks[16], (D_FF, D_MODEL), D_FF ** -0.5)
    norm_final_g = 1.0 + n(ks[17], (D_MODEL,), 0.02)
    return {"x": x, "norm_mix_g": norm_mix_g, "w_in": w_in, "conv_w": conv_w,
            "conv_b": conv_b, "lru_wa": lru_wa, "lru_ba": lru_ba, "lru_wx": lru_wx,
            "lru_bx": lru_bx, "lru_lambda": lru_lambda, "forget_b": forget_b,
            "w_branch_a": w_branch_a, "w_branch_b": w_branch_b, "w_out": w_out,
            "norm_mlp_g": norm_mlp_g, "w_up": w_up, "w_down": w_down,
            "norm_final_g": norm_final_g}


def reference(x, norm_mix_g, w_in, conv_w, conv_b, lru_wa, lru_ba, lru_wx, lru_bx,
              lru_lambda, forget_b, w_branch_a, w_branch_b, w_out, norm_mlp_g,
              w_up, w_down, norm_final_g):
    B, S, _ = x.shape
    for _layer in range(DEPTH):
        u = rms_norm(x, norm_mix_g)
        proj = u @ w_in
        cuts = list(np.cumsum(IN_SPLITS)[:-1])
        x_lru, g_lru, q, k, v, gates, f_logit = jnp.split(proj, cuts, axis=-1)

        xa = causal_depthwise_conv(x_lru, conv_w, conv_b)
        ha = rg_lru(xa, lru_wa, lru_ba, lru_wx, lru_bx, lru_lambda)
        ya = (jax.nn.gelu(g_lru) * ha) @ w_branch_a

        log_f = jax.nn.log_sigmoid((f_logit + forget_b).astype(jnp.float32))
        qh = q.reshape(B, S, N_HEADS, HEAD_DIM)
        kh = k.reshape(B, S, N_HEADS, HEAD_DIM)
        vh = v.reshape(B, S, N_HEADS, HEAD_DIM)
        ob = fox_attention(qh, kh, vh, log_f).reshape(B, S, D_ATTN)
        yb = ob @ w_branch_b

        g_a, g_b = jnp.split(jax.nn.sigmoid(gates), N_BRANCH, axis=-1)
        x = x + (g_a * ya + g_b * yb) @ w_out

        m = rms_norm(x, norm_mlp_g)
        h = jnp.square(jax.nn.relu(m @ w_up))
        x = x + h @ w_down
    return rms_norm(x, norm_final_g)
```

```cpp
#include <hip/hip_runtime.h>
#include <hip/hip_bf16.h>
#include <hip/hip_cooperative_groups.h>
#include <cstdio>
#include <cstdint>
#include <cmath>
namespace cg = cooperative_groups;

__device__ __forceinline__ int fresh_lane() { int l; asm volatile("v_mbcnt_lo_u32_b32 %0, -1, 0\n\tv_mbcnt_hi_u32_b32 %0, -1, %0" : "=v"(l)); return l; }

namespace pg8 {
#define PG8_LAS __attribute__((address_space(3)))
typedef unsigned short bf16_t;
typedef short bf16x8 __attribute__((ext_vector_type(8)));
typedef float f32x4 __attribute__((ext_vector_type(4)));
typedef unsigned u32x4 __attribute__((ext_vector_type(4)));
constexpr int BM = 256, BK = 64, HALF = 128, HTB = HALF * BK * 2  , STAGE_BYTES = 8 * HTB, NXCD = 8, WGM = 4;

__host__ __device__ __forceinline__ int lds_byte(int r, int c) { const int st = (r >> 4) * 2 + (c >> 5), rr = r & 15, cc = c & 31, ob = rr * 64 + cc * 2; return st * 1024 + (ob ^ (((ob >> 9) & 1) << 5)); }
__host__ __device__ __forceinline__ void stage_rc(int b, int& R, int& C) { const int st = b / 1024, sb = b % 1024, swz = sb ^ (((sb >> 9) & 1) << 5); R = (st >> 1) * 16 + swz / 64; C = (st & 1) * 32 + (swz % 64) / 2; }
__host__ __device__ __forceinline__ int perm32(int rho) { const int n = rho >> 4, i = rho & 15; return 8 * (i >> 2) + 4 * n + (i & 3); }

struct Unit { int pm, pn; };
struct Gemm { const bf16_t* A; const bf16_t* Bt; int M, N, K; const bf16_t* A2; const bf16_t* Bt2; };

struct StaticOrder {
    int nM, nN, nwg, G, c;
    __host__ __device__ void init(int M, int N, int G_, int c_) { nM = M / BM; nN = N / BM; nwg = nM * nN; G = G_; c = c_; }
    __host__ __device__ bool next(int i, Unit& u) const {
        const long L = (long)i * G + c; if (L >= nwg) return false;
        int wgid = (int)L; { const int q = nwg / NXCD, r = nwg % NXCD, xcd = wgid % NXCD, off = wgid / NXCD; wgid = (xcd < r ? xcd * (q + 1) : r * (q + 1) + (xcd - r) * q) + off; }
        const int nig = WGM * nN, gid = wgid / nig, fm = gid * WGM, gsz = (nM - fm) < WGM ? (nM - fm) : WGM;
        u.pm = fm + ((wgid % nig) % gsz); u.pn = (wgid % nig) / gsz; return true;
    }
    __device__ __forceinline__ void a_ready(const Unit&) const {}
    __device__ __forceinline__ void done(const Unit&) const {}
};

__device__ __forceinline__ unsigned cvt_pk_bf16(float lo, float hi) { unsigned r; asm volatile("v_cvt_pk_bf16_f32 %0, %1, %2" : "=v"(r) : "v"(lo), "v"(hi)); return r; }
typedef float f32x2 __attribute__((ext_vector_type(2)));
__device__ __forceinline__ f32x2 gelu_pk(f32x2 v) {
    const f32x2 av = __builtin_elementwise_abs(v), d = av * 0.2316418882f + 1.0f;
    f32x2 t; t.x = __builtin_amdgcn_rcpf(d.x); t.y = __builtin_amdgcn_rcpf(d.y);
    f32x2 q = t * 0.5307027145f + (-0.7265760135f); q = q * t + 0.7107068705f; q = q * t + (-0.142248368f); q = q * t + 0.127414796f; q = q * t;
    const f32x2 s = (v * v) * (-0.72134752044f);
    f32x2 e; e.x = __builtin_amdgcn_exp2f(s.x); e.y = __builtin_amdgcn_exp2f(s.y);
    const f32x2 m = v * (q * e), r = v - m;
    f32x2 o; o.x = v.x < 0.f ? m.x : r.x; o.y = v.y < 0.f ? m.y : r.y; return o;
}

template <int ACT  > struct EpiBf16 {
    static constexpr bool PERM = true, AFTER_DRAIN = false; static_assert(ACT == 0 || ACT == 1, "EpiBf16: ACT is 0 (none) or 1 (gelu_pk)");
    bf16_t* O; int ldc; const float* bias; int split_cols; size_t split_stride; float scale0;
    __device__ __forceinline__ void operator()(const f32x4 (&acc)[2][2][4][2], const Unit& u, int wr, int wc, int fr, int fq) const {
        const int row0 = u.pm * BM + wr * 64 + fr; int colt = u.pn * BM; bf16_t* base = O;
        float sc = 1.f; if (split_cols) { const int t = colt / split_cols; base += (size_t)t * split_stride; colt -= t * split_cols; if (t == 0) sc = scale0; }
        const int col0 = colt + wc * 32 + 8 * fq, bcol0 = u.pn * BM + wc * 32 + 8 * fq;
        f32x4 bv[2][2];
#pragma unroll
        for (int bj = 0; bj < 2; ++bj)
#pragma unroll
            for (int n = 0; n < 2; ++n) bv[bj][n] = bias ? *(const f32x4*)(bias + bcol0 + bj * HALF + 4 * n) : (f32x4){0.f, 0.f, 0.f, 0.f};
#pragma unroll
        for (int ai = 0; ai < 2; ++ai)
#pragma unroll
            for (int m = 0; m < 4; ++m) { bf16_t* rowp = base + (size_t)(row0 + ai * HALF + m * 16) * ldc + col0;
#pragma unroll
                for (int bj = 0; bj < 2; ++bj) { f32x4 v0 = acc[ai][bj][m][0] + bv[bj][0], v1 = acc[ai][bj][m][1] + bv[bj][1];
                    if (ACT == 1) { f32x2 a = gelu_pk((f32x2){v0[0], v0[1]}), b = gelu_pk((f32x2){v0[2], v0[3]}), c = gelu_pk((f32x2){v1[0], v1[1]}), d = gelu_pk((f32x2){v1[2], v1[3]});
                        v0 = (f32x4){a.x, a.y, b.x, b.y}; v1 = (f32x4){c.x, c.y, d.x, d.y}; }
                    v0 = v0 * sc; v1 = v1 * sc; u32x4 w; w.x = cvt_pk_bf16(v0[0], v0[1]); w.y = cvt_pk_bf16(v0[2], v0[3]); w.z = cvt_pk_bf16(v1[0], v1[1]); w.w = cvt_pk_bf16(v1[2], v1[3]);
                    *(u32x4*)(rowp + bj * HALF) = w; } }
    }
};
template <class Epi, class Sched, bool ALIGN_EPI = false, bool SP2 = false, bool TWO = false>
__device__ __forceinline__ void gemm_phase(PG8_LAS unsigned char* lds, const Gemm g, const Sched& S, const Epi& E, const int wave_s) {
    const int lane = fresh_lane(), wid = wave_s, tid = wid * 64 + lane, wr = wid >> 2, wc = wid & 3, fr = lane & 15, fq = lane >> 4;
    const int K = g.K, nt = K / BK, LD = TWO ? K / 2 : K, nt1 = TWO ? nt / 2 : nt; (void)nt1;
    unsigned voffA[2], voffB[2];
#pragma unroll
    for (int i = 0; i < 2; ++i) { int R, C; stage_rc(tid * 16 + i * 8192, R, C); const int Rb = Epi::PERM ? ((R & ~31) + perm32(R & 31)) : R;
        voffA[i] = (unsigned)(R * LD + C) * 2u; voffB[i] = (unsigned)(Rb * LD + C) * 2u; }
    const size_t kstep = (size_t)(BK * 2);
    const size_t hstep = (size_t)HALF * LD * 2;
    const size_t tstep = 2 * hstep;
    const unsigned ldsw = (unsigned)wid * 1024u;
    const int aoff = lds_byte(wr * 64 + fr, fq * 8), boff = lds_byte(wc * 32 + fr, fq * 8);
#define PG8_SA(b, h) (((b) * 2 + (h)) * HTB)
#define PG8_SB(b, h) ((4 + (b) * 2 + (h)) * HTB)
#define PG8_STAGE(bufoff, gbase, voff) do { _Pragma("unroll") for (int _i = 0; _i < 2; ++_i) \
        __builtin_amdgcn_global_load_lds((const unsigned*)((const char*)(gbase) + (voff)[_i]), (PG8_LAS unsigned*)(lds + (bufoff) + ldsw + _i * 8192), 16, 0, 0); } while (0)
#define PG8_LDA(dst, b, h) do { _Pragma("unroll") for (int m = 0; m < 4; ++m) _Pragma("unroll") for (int k = 0; k < 2; ++k) dst[m][k] = *(const PG8_LAS bf16x8*)(lds + PG8_SA(b, h) + aoff + m * 2048 + k * 1024); } while (0)
#define PG8_LDB(dst, b, h) do { _Pragma("unroll") for (int n = 0; n < 2; ++n) _Pragma("unroll") for (int k = 0; k < 2; ++k) dst[n][k] = *(const PG8_LAS bf16x8*)(lds + PG8_SB(b, h) + boff + n * 2048 + k * 1024); } while (0)
#define PG8_MMA(ai, bj, At, Bt) do { __builtin_amdgcn_s_setprio(1); _Pragma("unroll") for (int m = 0; m < 4; ++m) _Pragma("unroll") for (int n = 0; n < 2; ++n) _Pragma("unroll") for (int k = 0; k < 2; ++k) \
        acc[ai][bj][m][n] = __builtin_amdgcn_mfma_f32_16x16x32_bf16(Bt[n][k], At[m][k], acc[ai][bj][m][n], 0, 0, 0); __builtin_amdgcn_s_setprio(0); } while (0)
#define PG8_WAIT_V(n) asm volatile("s_waitcnt vmcnt(" #n ")" ::: "memory")
#define PG8_WAIT_L(n) asm volatile("s_waitcnt lgkmcnt(" #n ")" ::: "memory")
#define PG8_BAR __builtin_amdgcn_s_barrier()
#define PG8_SCHED __builtin_amdgcn_sched_barrier(0)
    Unit cur, nxt; int ui = 0;
    if (!S.next(0, cur)) return;
    f32x4 acc[2][2][4][2];
#pragma unroll
    for (int a = 0; a < 2; ++a)
#pragma unroll
        for (int b = 0; b < 2; ++b)
#pragma unroll
            for (int m = 0; m < 4; ++m)
#pragma unroll
                for (int n = 0; n < 2; ++n) acc[a][b][m][n] = (f32x4){0.f, 0.f, 0.f, 0.f};
    bf16x8 At[4][2], B0[2][2], B1[2][2];
    const char* cA = (const char*)g.A + (size_t)cur.pm * tstep; const char* cB = (const char*)g.Bt + (size_t)cur.pn * tstep;
    const char* cA2 = TWO ? (const char*)g.A2 + (size_t)cur.pm * tstep - (size_t)nt1 * kstep : cA; const char* cB2 = TWO ? (const char*)g.Bt2 + (size_t)cur.pn * tstep - (size_t)nt1 * kstep : cB;
    S.a_ready(cur);
    if constexpr (SP2) {
        PG8_STAGE(PG8_SB(0, 0), cB, voffB); PG8_STAGE(PG8_SB(0, 1), cB + hstep, voffB); PG8_STAGE(PG8_SA(0, 0), cA, voffA); PG8_STAGE(PG8_SA(0, 1), cA + hstep, voffA);
        if (wr == 1) PG8_BAR;
        PG8_WAIT_V(2); PG8_BAR;
        PG8_STAGE(PG8_SB(1, 0), cB + kstep, voffB); PG8_STAGE(PG8_SA(1, 0), cA + kstep, voffA); PG8_STAGE(PG8_SB(1, 1), cB + hstep + kstep, voffB);
        PG8_WAIT_V(6); PG8_BAR;
    } else {
        PG8_STAGE(PG8_SB(0, 0), cB, voffB); PG8_STAGE(PG8_SA(0, 0), cA, voffA); PG8_STAGE(PG8_SB(0, 1), cB + hstep, voffB); PG8_STAGE(PG8_SA(0, 1), cA + hstep, voffA);
        if (wr == 1) PG8_BAR;
        PG8_WAIT_V(4); PG8_BAR;
        PG8_STAGE(PG8_SB(1, 0), cB + kstep, voffB); PG8_STAGE(PG8_SA(1, 0), cA + kstep, voffA); PG8_STAGE(PG8_SB(1, 1), cB + hstep + kstep, voffB);
        PG8_WAIT_V(6); PG8_BAR;
    }
    for (;;) {
        const bool has_next = S.next(ui + 1, nxt);
        const char* nA = has_next ? (const char*)g.A + (size_t)nxt.pm * tstep : cA; const char* nB = has_next ? (const char*)g.Bt + (size_t)nxt.pn * tstep : cB;
        for (int t = 0; t < nt; t += 2) {
            const bool last = (t == nt - 2);
            const char* a1 = ((TWO && t >= nt1) ? cA2 : cA) + (size_t)(t + 1) * kstep;
            const char* a2 = last ? nA : ((TWO && t + 2 >= nt1) ? cA2 : cA) + (size_t)(t + 2) * kstep; const char* b2 = last ? nB : ((TWO && t + 2 >= nt1) ? cB2 : cB) + (size_t)(t + 2) * kstep;
            const char* a3 = a2 + kstep; const char* b3 = b2 + kstep;
            if (last && has_next) S.a_ready(nxt);
            if constexpr (SP2) {
            PG8_LDB(B0, 0, 0); PG8_LDB(B1, 0, 1); PG8_SCHED; PG8_LDA(At, 0, 0); PG8_STAGE(PG8_SA(1, 1), a1 + hstep, voffA);
            PG8_WAIT_V(8); PG8_WAIT_L(0); PG8_BAR; PG8_MMA(0, 0, At, B0); PG8_MMA(0, 1, At, B1); PG8_BAR; PG8_SCHED;
            PG8_LDA(At, 0, 1); PG8_STAGE(PG8_SB(0, 0), b2, voffB); PG8_STAGE(PG8_SB(0, 1), b2 + hstep, voffB); PG8_STAGE(PG8_SA(0, 0), a2, voffA);
            PG8_WAIT_V(8); PG8_WAIT_L(0); PG8_BAR; PG8_MMA(1, 0, At, B0); PG8_MMA(1, 1, At, B1); PG8_BAR; PG8_SCHED;
            PG8_LDB(B0, 1, 0); PG8_LDB(B1, 1, 1); PG8_SCHED; PG8_LDA(At, 1, 0); PG8_STAGE(PG8_SA(0, 1), a2 + hstep, voffA);
            PG8_WAIT_V(8); PG8_WAIT_L(0); PG8_BAR; PG8_MMA(0, 0, At, B0); PG8_MMA(0, 1, At, B1); PG8_BAR; PG8_SCHED;
            PG8_LDA(At, 1, 1); PG8_STAGE(PG8_SB(1, 0), b3, voffB); PG8_STAGE(PG8_SB(1, 1), b3 + hstep, voffB); PG8_STAGE(PG8_SA(1, 0), a3, voffA);
            PG8_WAIT_V(8); PG8_WAIT_L(0); PG8_BAR; PG8_MMA(1, 0, At, B0); PG8_MMA(1, 1, At, B1); PG8_BAR; PG8_SCHED;
            } else {
            PG8_LDB(B0, 0, 0); PG8_SCHED; PG8_LDA(At, 0, 0); PG8_STAGE(PG8_SA(1, 1), a1 + hstep, voffA);
            PG8_WAIT_L(8); PG8_BAR; PG8_WAIT_L(0); PG8_MMA(0, 0, At, B0); PG8_BAR; PG8_SCHED;
            PG8_LDB(B1, 0, 1); PG8_STAGE(PG8_SB(0, 0), b2, voffB);
            PG8_BAR; PG8_WAIT_L(0); PG8_MMA(0, 1, At, B1); PG8_BAR;
            PG8_LDA(At, 0, 1); PG8_STAGE(PG8_SA(0, 0), a2, voffA);
            PG8_BAR; PG8_WAIT_L(0); PG8_MMA(1, 0, At, B0); PG8_BAR; PG8_SCHED;
            PG8_STAGE(PG8_SB(0, 1), b2 + hstep, voffB);
            PG8_WAIT_V(6); PG8_BAR; PG8_MMA(1, 1, At, B1); PG8_BAR;
            PG8_LDB(B0, 1, 0); PG8_SCHED; PG8_LDA(At, 1, 0); PG8_STAGE(PG8_SA(0, 1), a2 + hstep, voffA);
            PG8_WAIT_L(8); PG8_BAR; PG8_WAIT_L(0); PG8_MMA(0, 0, At, B0); PG8_BAR; PG8_SCHED;
            PG8_LDB(B1, 1, 1); PG8_STAGE(PG8_SB(1, 0), b3, voffB);
            PG8_BAR; PG8_WAIT_L(0); PG8_MMA(0, 1, At, B1); PG8_BAR;
            PG8_LDA(At, 1, 1); PG8_STAGE(PG8_SA(1, 0), a3, voffA);
            PG8_BAR; PG8_WAIT_L(0); PG8_MMA(1, 0, At, B0); PG8_BAR; PG8_SCHED;
            PG8_STAGE(PG8_SB(1, 1), b3 + hstep, voffB);
            PG8_WAIT_V(6); PG8_BAR; PG8_MMA(1, 1, At, B1); PG8_BAR;
            }
            if constexpr (TWO) { if (t == nt1 - 2) E.mid(acc, cur, wr, wc, fr, fq); }
        }
        if constexpr (ALIGN_EPI) { if (wr == 0) PG8_BAR; }
        if constexpr (!Epi::AFTER_DRAIN) { E(acc, cur, wr, wc, fr, fq); S.done(cur); }
        if (!has_next) break;
#pragma unroll
        for (int a = 0; a < 2; ++a)
#pragma unroll
            for (int b = 0; b < 2; ++b)
#pragma unroll
                for (int m = 0; m < 4; ++m)
#pragma unroll
                    for (int n = 0; n < 2; ++n) acc[a][b][m][n] = (f32x4){0.f, 0.f, 0.f, 0.f};
        cur = nxt; cA = nA; cB = nB; ++ui;
        if constexpr (TWO) { cA2 = (const char*)g.A2 + (size_t)cur.pm * tstep - (size_t)nt1 * kstep; cB2 = (const char*)g.Bt2 + (size_t)cur.pn * tstep - (size_t)nt1 * kstep; }
        if constexpr (ALIGN_EPI) { if (wr == 1) PG8_BAR; }
    }
    PG8_WAIT_V(0);
    if constexpr (!ALIGN_EPI) { if (wr == 0) PG8_BAR; }
    PG8_BAR;
    if constexpr (Epi::AFTER_DRAIN) { E.fused(acc, cur, wr, wc, fr, fq, lds, wid, lane); S.done(cur); }
#undef PG8_SA
#undef PG8_SB
#undef PG8_STAGE
#undef PG8_LDA
#undef PG8_LDB
#undef PG8_MMA
#undef PG8_WAIT_V
#undef PG8_WAIT_L
#undef PG8_BAR
#undef PG8_SCHED
}
}

namespace pg8 {
__device__ __forceinline__ float e_lo(unsigned w) { return __uint_as_float(w << 16); }
__device__ __forceinline__ float e_hi(unsigned w) { return __uint_as_float(w & 0xffff0000u); }
__device__ __forceinline__ float e_sig(float x) { return __builtin_amdgcn_rcpf(1.f + __expf(-x)); }
struct EpiGateA {
    static constexpr bool PERM = true, AFTER_DRAIN = false;
    const bf16_t* gate; bf16_t* T;
    __device__ __forceinline__ void operator()(const f32x4 (&acc)[2][2][4][2], const Unit& u, int wr, int wc, int fr, int fq) const {
        const int row0 = u.pm * BM + wr * 64 + fr, col0 = u.pn * BM + wc * 32 + 8 * fq;
#pragma unroll
        for (int ai = 0; ai < 2; ++ai)
#pragma unroll
            for (int m = 0; m < 4; ++m) { const size_t ro = (size_t)(row0 + ai * HALF + m * 16) * 1024 + col0;
#pragma unroll
                for (int bj = 0; bj < 2; ++bj) { const size_t off = ro + bj * HALF; const u32x4 g = *(const u32x4*)(gate + off);
                    const f32x4 v0 = acc[ai][bj][m][0], v1 = acc[ai][bj][m][1]; u32x4 w;
                    w.x = cvt_pk_bf16(v0[0] * e_sig(e_lo(g.x)), v0[1] * e_sig(e_hi(g.x))); w.y = cvt_pk_bf16(v0[2] * e_sig(e_lo(g.y)), v0[3] * e_sig(e_hi(g.y)));
                    w.z = cvt_pk_bf16(v1[0] * e_sig(e_lo(g.z)), v1[1] * e_sig(e_hi(g.z))); w.w = cvt_pk_bf16(v1[2] * e_sig(e_lo(g.w)), v1[3] * e_sig(e_hi(g.w)));
                    *(u32x4*)(T + off) = w; } }
    }
};
struct EpiGateB {
    static constexpr bool PERM = true, AFTER_DRAIN = false;
    const bf16_t* gate; bf16_t* T;
    __device__ __forceinline__ void operator()(const f32x4 (&acc)[2][2][4][2], const Unit& u, int wr, int wc, int fr, int fq) const {
        const int row0 = u.pm * BM + wr * 64 + fr, col0 = u.pn * BM + wc * 32 + 8 * fq;
#pragma unroll
        for (int ai = 0; ai < 2; ++ai)
#pragma unroll
            for (int m = 0; m < 4; ++m) { const size_t ro = (size_t)(row0 + ai * HALF + m * 16) * 1024 + col0;
#pragma unroll
                for (int bj = 0; bj < 2; ++bj) { const size_t off = ro + bj * HALF; const u32x4 g = *(const u32x4*)(gate + off); const u32x4 t = *(const u32x4*)(T + off);
                    const f32x4 v0 = acc[ai][bj][m][0], v1 = acc[ai][bj][m][1]; u32x4 w;
                    w.x = cvt_pk_bf16(e_lo(t.x) + v0[0] * e_sig(e_lo(g.x)), e_hi(t.x) + v0[1] * e_sig(e_hi(g.x))); w.y = cvt_pk_bf16(e_lo(t.y) + v0[2] * e_sig(e_lo(g.y)), e_hi(t.y) + v0[3] * e_sig(e_hi(g.y)));
                    w.z = cvt_pk_bf16(e_lo(t.z) + v1[0] * e_sig(e_lo(g.z)), e_hi(t.z) + v1[1] * e_sig(e_hi(g.z))); w.w = cvt_pk_bf16(e_lo(t.w) + v1[2] * e_sig(e_lo(g.w)), e_hi(t.w) + v1[3] * e_sig(e_hi(g.w)));
                    *(u32x4*)(T + off) = w; } }
    }
};
struct EpiRes1 {
    static constexpr bool PERM = true, AFTER_DRAIN = false;
    const float* x; bf16_t* xb; float* ssq;
    __device__ __forceinline__ void operator()(const f32x4 (&acc)[2][2][4][2], const Unit& u, int wr, int wc, int fr, int fq) const {
        const int row0 = u.pm * BM + wr * 64 + fr, col0 = u.pn * BM + wc * 32 + 8 * fq;
        size_t base = (size_t)row0 * 1024 + col0; asm volatile("" : "+v"(base));
        u32x4 R[2][4][2]; float S[2][4];
#pragma unroll
        for (int ai = 0; ai < 2; ++ai) {
            f32x4 L[4][2][2];
#pragma unroll
            for (int m = 0; m < 4; ++m)
#pragma unroll
                for (int bj = 0; bj < 2; ++bj) { const size_t off = base + (size_t)(ai * HALF + m * 16) * 1024 + bj * HALF; L[m][bj][0] = *(const f32x4*)(x + off); L[m][bj][1] = *(const f32x4*)(x + off + 4); }
            asm volatile("" ::: "memory");
#pragma unroll
            for (int m = 0; m < 4; ++m) { float s = 0.f;
#pragma unroll
                for (int bj = 0; bj < 2; ++bj) { const f32x4 a0 = L[m][bj][0] + acc[ai][bj][m][0], a1 = L[m][bj][1] + acc[ai][bj][m][1];
                    s += (a0[0] * a0[0] + a0[1] * a0[1]) + (a0[2] * a0[2] + a0[3] * a0[3]) + (a1[0] * a1[0] + a1[1] * a1[1]) + (a1[2] * a1[2] + a1[3] * a1[3]);
                    u32x4 w; w.x = cvt_pk_bf16(a0[0], a0[1]); w.y = cvt_pk_bf16(a0[2], a0[3]); w.z = cvt_pk_bf16(a1[0], a1[1]); w.w = cvt_pk_bf16(a1[2], a1[3]); R[ai][m][bj] = w; }
                s += __shfl_xor(s, 16); s += __shfl_xor(s, 32); S[ai][m] = s; }
            asm volatile("" ::: "memory");
        }
#pragma unroll
        for (int ai = 0; ai < 2; ++ai)
#pragma unroll
            for (int m = 0; m < 4; ++m) { const int row = row0 + ai * HALF + m * 16; const size_t ro = base + (size_t)(ai * HALF + m * 16) * 1024;
                *(u32x4*)(xb + ro) = R[ai][m][0]; *(u32x4*)(xb + ro + HALF) = R[ai][m][1];
                if (fq == 0) unsafeAtomicAdd(ssq + row, S[ai][m]); }
    }
};
struct EpiUp {
    static constexpr bool PERM = true, AFTER_DRAIN = false;
    const float* ssq; bf16_t* H;
    __device__ __forceinline__ void operator()(const f32x4 (&acc)[2][2][4][2], const Unit& u, int wr, int wc, int fr, int fq) const {
        const int row0 = u.pm * BM + wr * 64 + fr, col0 = u.pn * BM + wc * 32 + 8 * fq;
        float r2[2][4];
#pragma unroll
        for (int ai = 0; ai < 2; ++ai)
#pragma unroll
            for (int m = 0; m < 4; ++m) r2[ai][m] = ssq[row0 + ai * HALF + m * 16];
        asm volatile("" ::: "memory");
#pragma unroll
        for (int ai = 0; ai < 2; ++ai)
#pragma unroll
            for (int m = 0; m < 4; ++m) { const int row = row0 + ai * HALF + m * 16; const float rr = 1.0f / (r2[ai][m] * (1.0f / 1024.0f) + 1e-6f);
#pragma unroll
                for (int bj = 0; bj < 2; ++bj) { const size_t off = (size_t)row * 4096 + col0 + bj * HALF;
                    f32x4 v0 = acc[ai][bj][m][0], v1 = acc[ai][bj][m][1];
#pragma unroll
                    for (int i = 0; i < 4; ++i) { const float a = fmaxf(v0[i], 0.f), b = fmaxf(v1[i], 0.f); v0[i] = a * a * rr; v1[i] = b * b * rr; }
                    u32x4 w; w.x = cvt_pk_bf16(v0[0], v0[1]); w.y = cvt_pk_bf16(v0[2], v0[3]); w.z = cvt_pk_bf16(v1[0], v1[1]); w.w = cvt_pk_bf16(v1[2], v1[3]);
                    *(u32x4*)(H + off) = w; } }
    }
};
struct EpiDown {
    static constexpr bool PERM = true, AFTER_DRAIN = false;
    float* x1;
    __device__ __forceinline__ void operator()(const f32x4 (&acc)[2][2][4][2], const Unit& u, int wr, int wc, int fr, int fq) const {
        const int row0 = u.pm * BM + wr * 64 + fr, col0 = u.pn * BM + wc * 32 + 8 * fq;
#pragma unroll
        for (int ai = 0; ai < 2; ++ai)
#pragma unroll
            for (int m = 0; m < 4; ++m) { const size_t ro = (size_t)(row0 + ai * HALF + m * 16) * 1024 + col0;
#pragma unroll
                for (int bj = 0; bj < 2; ++bj) { const size_t off = ro + bj * HALF;
                    const f32x4 a0 = *(const f32x4*)(x1 + off) + acc[ai][bj][m][0], a1 = *(const f32x4*)(x1 + off + 4) + acc[ai][bj][m][1];
                    *(f32x4*)(x1 + off) = a0; *(f32x4*)(x1 + off + 4) = a1; } }
    }
};

struct EpiDownNorm {
    static constexpr bool PERM = true, AFTER_DRAIN = false;
    const bf16_t* x1; float* out; const float* gfin; float* ssq; unsigned* cnt;
    __device__ __forceinline__ void operator()(const f32x4 (&acc_)[2][2][4][2], const Unit& u, int wr, int wc, int fr, int fq) const {
        f32x4 (&acc)[2][2][4][2] = const_cast<f32x4 (&)[2][2][4][2]>(acc_);
        const int row0 = u.pm * BM + wr * 64 + fr, col0 = u.pn * BM + wc * 32 + 8 * fq;
        size_t base = (size_t)row0 * 1024 + col0; asm volatile("" : "+v"(base));
        float S[2][4];
        {
            u32x4 L[2][4][2];
#pragma unroll
            for (int ai = 0; ai < 2; ++ai)
#pragma unroll
                for (int m = 0; m < 4; ++m)
#pragma unroll
                    for (int bj = 0; bj < 2; ++bj) L[ai][m][bj] = *(const u32x4*)(x1 + base + (size_t)(ai * HALF + m * 16) * 1024 + bj * HALF);
            asm volatile("" ::: "memory");
#pragma unroll
            for (int ai = 0; ai < 2; ++ai)
#pragma unroll
                for (int m = 0; m < 4; ++m) { float s = 0.f;
#pragma unroll
                    for (int bj = 0; bj < 2; ++bj) { const u32x4 xr = L[ai][m][bj];
                        const f32x4 a0 = (f32x4){e_lo(xr.x), e_hi(xr.x), e_lo(xr.y), e_hi(xr.y)} + acc[ai][bj][m][0], a1 = (f32x4){e_lo(xr.z), e_hi(xr.z), e_lo(xr.w), e_hi(xr.w)} + acc[ai][bj][m][1];
                        acc[ai][bj][m][0] = a0; acc[ai][bj][m][1] = a1;
                        s += (a0[0] * a0[0] + a0[1] * a0[1]) + (a0[2] * a0[2] + a0[3] * a0[3]) + (a1[0] * a1[0] + a1[1] * a1[1]) + (a1[2] * a1[2] + a1[3] * a1[3]); }
                    s += __shfl_xor(s, 16); s += __shfl_xor(s, 32); S[ai][m] = s; }
        }
        asm volatile("" ::: "memory");
        if (fq == 0) {
#pragma unroll
            for (int ai = 0; ai < 2; ++ai)
#pragma unroll
                for (int m = 0; m < 4; ++m) unsafeAtomicAdd(ssq + row0 + ai * HALF + m * 16, S[ai][m]); }
        asm volatile("s_waitcnt vmcnt(0)" ::: "memory");
        unsigned* pc = cnt + 64 * u.pm;
        if (fr == 0 && fq == 0) __hip_atomic_fetch_add(pc, 1u, __ATOMIC_RELAXED, __HIP_MEMORY_SCOPE_AGENT);
        f32x4 gv[2][2];
#pragma unroll
        for (int bj = 0; bj < 2; ++bj) { gv[bj][0] = *(const f32x4*)(gfin + col0 + bj * HALF); gv[bj][1] = *(const f32x4*)(gfin + col0 + bj * HALF + 4); }
        { unsigned sp = 0; while ((unsigned)__builtin_amdgcn_readfirstlane(__hip_atomic_load(pc, __ATOMIC_RELAXED, __HIP_MEMORY_SCOPE_AGENT)) < 32u) { __builtin_amdgcn_s_sleep(2); if (++sp > (1u << 22)) break; } }
        float tot[2][4];
#pragma unroll
        for (int ai = 0; ai < 2; ++ai)
#pragma unroll
            for (int m = 0; m < 4; ++m) tot[ai][m] = __hip_atomic_load(ssq + row0 + ai * HALF + m * 16, __ATOMIC_RELAXED, __HIP_MEMORY_SCOPE_AGENT);
        asm volatile("" ::: "memory");
#pragma unroll
        for (int ai = 0; ai < 2; ++ai)
#pragma unroll
            for (int m = 0; m < 4; ++m) { const size_t ro = base + (size_t)(ai * HALF + m * 16) * 1024;
                const float rstd = 1.0f / sqrtf(tot[ai][m] * (1.0f / 1024.0f) + 1e-6f);
#pragma unroll
                for (int bj = 0; bj < 2; ++bj) { const size_t off = ro + bj * HALF;
                    *(f32x4*)(out + off) = acc[ai][bj][m][0] * rstd * gv[bj][0]; *(f32x4*)(out + off + 4) = acc[ai][bj][m][1] * rstd * gv[bj][1]; } }
    }
};

struct EpiMix {
    static constexpr bool PERM = true, AFTER_DRAIN = false;
    const bf16_t* ga; const bf16_t* gb; bf16_t* T;
    __device__ __forceinline__ void mid(f32x4 (&acc)[2][2][4][2], const Unit& u, int wr, int wc, int fr, int fq) const {
        const int row0 = u.pm * BM + wr * 64 + fr, col0 = u.pn * BM + wc * 32 + 8 * fq;
        size_t base = (size_t)row0 * 1024 + col0; asm volatile("" : "+v"(base));
#pragma unroll
        for (int ai = 0; ai < 2; ++ai) {
            u32x4 A[4][2], B[4][2];
#pragma unroll
            for (int m = 0; m < 4; ++m)
#pragma unroll
                for (int bj = 0; bj < 2; ++bj) { const size_t off = base + (size_t)(ai * HALF + m * 16) * 1024 + bj * HALF; A[m][bj] = *(const u32x4*)(ga + off); B[m][bj] = *(const u32x4*)(gb + off); }
            asm volatile("" ::: "memory");
#pragma unroll
            for (int m = 0; m < 4; ++m)
#pragma unroll
                for (int bj = 0; bj < 2; ++bj) { const u32x4 a = A[m][bj], b = B[m][bj];
#pragma unroll
                    for (int w = 0; w < 4; ++w) { const float r0 = (1.f + __expf(-fmaxf(e_lo(b[w]), -80.f))) * __builtin_amdgcn_rcpf(1.f + __expf(-e_lo(a[w]))), r1 = (1.f + __expf(-fmaxf(e_hi(b[w]), -80.f))) * __builtin_amdgcn_rcpf(1.f + __expf(-e_hi(a[w])));
                        acc[ai][bj][m][w >> 1][2 * (w & 1)] *= r0; acc[ai][bj][m][w >> 1][2 * (w & 1) + 1] *= r1; } }
            asm volatile("" ::: "memory");
        }
    }
    __device__ __forceinline__ void operator()(const f32x4 (&acc)[2][2][4][2], const Unit& u, int wr, int wc, int fr, int fq) const {
        const int row0 = u.pm * BM + wr * 64 + fr, col0 = u.pn * BM + wc * 32 + 8 * fq;
        size_t base = (size_t)row0 * 1024 + col0; asm volatile("" : "+v"(base));
        u32x4 Gt[2][4][2];
#pragma unroll
        for (int ai = 0; ai < 2; ++ai)
#pragma unroll
            for (int m = 0; m < 4; ++m)
#pragma unroll
                for (int bj = 0; bj < 2; ++bj) Gt[ai][m][bj] = *(const u32x4*)(gb + base + (size_t)(ai * HALF + m * 16) * 1024 + bj * HALF);
        asm volatile("" ::: "memory");
#pragma unroll
        for (int ai = 0; ai < 2; ++ai)
#pragma unroll
            for (int m = 0; m < 4; ++m)
#pragma unroll
                for (int bj = 0; bj < 2; ++bj) { const u32x4 g = Gt[ai][m][bj]; const f32x4 v0 = acc[ai][bj][m][0], v1 = acc[ai][bj][m][1]; u32x4 w;
                    w.x = cvt_pk_bf16(v0[0] * e_sig(fmaxf(e_lo(g.x), -80.f)), v0[1] * e_sig(fmaxf(e_hi(g.x), -80.f))); w.y = cvt_pk_bf16(v0[2] * e_sig(fmaxf(e_lo(g.y), -80.f)), v0[3] * e_sig(fmaxf(e_hi(g.y), -80.f)));
                    w.z = cvt_pk_bf16(v1[0] * e_sig(fmaxf(e_lo(g.z), -80.f)), v1[1] * e_sig(fmaxf(e_hi(g.z), -80.f))); w.w = cvt_pk_bf16(v1[2] * e_sig(fmaxf(e_lo(g.w), -80.f)), v1[3] * e_sig(fmaxf(e_hi(g.w), -80.f)));
                    Gt[ai][m][bj] = w; }
        asm volatile("" ::: "memory");
#pragma unroll
        for (int ai = 0; ai < 2; ++ai)
#pragma unroll
            for (int m = 0; m < 4; ++m)
#pragma unroll
                for (int bj = 0; bj < 2; ++bj) *(u32x4*)(T + base + (size_t)(ai * HALF + m * 16) * 1024 + bj * HALF) = Gt[ai][m][bj];
    }
};

struct EpiNull { static constexpr bool PERM = true, AFTER_DRAIN = false;
    __device__ __forceinline__ void operator()(const f32x4 (&acc)[2][2][4][2], const Unit& u, int wr, int wc, int fr, int fq) const { float s = 0.f;
#pragma unroll
        for (int a = 0; a < 2; ++a)
#pragma unroll
            for (int b = 0; b < 2; ++b)
#pragma unroll
                for (int m = 0; m < 4; ++m)
#pragma unroll
                    for (int n = 0; n < 2; ++n) s += (acc[a][b][m][n][0] + acc[a][b][m][n][1]) + (acc[a][b][m][n][2] + acc[a][b][m][n][3]);
        if (s == 123456.789f) asm volatile("s_nop 0"); } };

struct EpiProj {
    static constexpr bool PERM = true, AFTER_DRAIN = false;
    bf16_t* O; size_t split_stride; unsigned* KP;
    __device__ __forceinline__ void operator()(const f32x4 (&acc)[2][2][4][2], const Unit& u, int wr, int wc, int fr, int fq) const {
        const int plane = u.pn >> 2; bf16_t* base = O + (size_t)plane * split_stride;
        const int row0 = u.pm * BM + wr * 64 + fr, col0 = (u.pn & 3) * BM + wc * 32 + 8 * fq;
#pragma unroll
        for (int ai = 0; ai < 2; ++ai)
#pragma unroll
            for (int m = 0; m < 4; ++m) { bf16_t* rowp = base + (size_t)(row0 + ai * HALF + m * 16) * 1024 + col0;
#pragma unroll
                for (int bj = 0; bj < 2; ++bj) { const f32x4 v0 = acc[ai][bj][m][0], v1 = acc[ai][bj][m][1];
                    u32x4 w; w.x = cvt_pk_bf16(v0[0], v0[1]); w.y = cvt_pk_bf16(v0[2], v0[3]); w.z = cvt_pk_bf16(v1[0], v1[1]); w.w = cvt_pk_bf16(v1[2], v1[3]);
                    *(u32x4*)(rowp + bj * HALF) = w; } }
        if (plane == 3) {
#pragma unroll
            for (int bj = 0; bj < 2; ++bj) { float mx = 0.f;
#pragma unroll
                for (int ai = 0; ai < 2; ++ai)
#pragma unroll
                    for (int m = 0; m < 4; ++m) { const f32x4 v0 = acc[ai][bj][m][0], v1 = acc[ai][bj][m][1];
                        float ss = (v0[0] * v0[0] + v0[1] * v0[1]) + (v0[2] * v0[2] + v0[3] * v0[3]) + (v1[0] * v1[0] + v1[1] * v1[1]) + (v1[2] * v1[2] + v1[3] * v1[3]);
                        ss += __shfl_xor(ss, 16); ss += __shfl_xor(ss, 32); mx = fmaxf(mx, ss); }
                mx = fmaxf(mx, __shfl_xor(mx, 1)); mx = fmaxf(mx, __shfl_xor(mx, 2)); mx = fmaxf(mx, __shfl_xor(mx, 4)); mx = fmaxf(mx, __shfl_xor(mx, 8));
                if (fr == 0 && fq == 0) atomicMax(KP + (((u.pm >> 5) * 8 + 2 * (u.pn & 3) + bj) * 4 + wc), __float_as_uint(mx)); }
        }
    }
};
}

namespace att {
constexpr int D = 128, PITCH = 1024;
constexpr float THR = 8.f;
constexpr bool WSKIP = false;
constexpr float SCALE = 0.08838834764831845f;
constexpr int NW = 8, QBLK = 32, KVBLK = 64, QB = NW * QBLK;
constexpr int SHM_V = KVBLK * D * 2, SHM_K = KVBLK * D * 2;
constexpr int ATT_LDS_BYTES = 2 * SHM_V + 2 * SHM_K + NW * 64 * 4 + 2 * 64 * 4;
using bf16 = __hip_bfloat16;
typedef short bf16x8 __attribute__((ext_vector_type(8)));
typedef short s16x4 __attribute__((ext_vector_type(4)));
typedef float f32x16 __attribute__((ext_vector_type(16)));
typedef float f32x4 __attribute__((ext_vector_type(4)));
typedef unsigned u32x4 __attribute__((ext_vector_type(4)));
template <class A, class Bt> struct same_t { static constexpr bool v = false; };
template <class A> struct same_t<A, A> { static constexpr bool v = true; };

#define KSWZ(row, colB) ((row) * 256 + ((colB) ^ (((row) & 7) << 4)))
#define SBAR() __builtin_amdgcn_sched_barrier(0)
__device__ __forceinline__ int v_st(int k, int c) { const int kk = (k & ~0xC) | ((k & 4) << 1) | ((k & 8) >> 1); return ((kk >> 3) * 4 + (c >> 5)) * 512 + ((kk & 7) * 32 + (c & 31)) * 2; }
__device__ __forceinline__ int v_rd_base(int lane) { return ((lane & 3) << 3) | (((lane >> 2) & 3) << 6) | (((lane >> 4) & 1) << 5) | (((lane >> 5) & 1) << 8); }
constexpr int v_rd_off(int d0, int ks, int half) { return d0 * 512 + ks * 4096 + half * 2048; }
__device__ __forceinline__ int crow(int r, int hi) { return (r & 3) + 8 * (r >> 2) + 4 * hi; }
__device__ __forceinline__ unsigned cvtpk(float lo, float hi) {
    unsigned r; asm volatile("v_cvt_pk_bf16_f32 %0, %1, %2" : "=v"(r) : "v"(lo), "v"(hi)); return r;
}
__device__ __forceinline__ bf16x8 pack8(f32x4 a, f32x4 b) {
    u32x4 w = {cvtpk(a[0], a[1]), cvtpk(a[2], a[3]), cvtpk(b[0], b[1]), cvtpk(b[2], b[3])};
    return *reinterpret_cast<bf16x8*>(&w);
}
template <class T> __device__ __forceinline__ bf16x8 load8(const T* p) {
    if constexpr (same_t<T, float>::v) { return pack8(*(const f32x4*)p, *(const f32x4*)(p + 4)); }
    else { return *reinterpret_cast<const bf16x8*>(p); }
}
__device__ __forceinline__ void mask_tile(f32x16& p0, f32x16& p1, int dq, unsigned W) {
    const float NEG = -__builtin_inff();
#pragma unroll
    for (int r = 0; r < 16; ++r) {
        const int c = (r & 3) + 8 * (r >> 2);
        if ((unsigned)(dq - c) >= W) p0[r] = NEG;
        if ((unsigned)(dq - c - 32) >= W) p1[r] = NEG;
    }
}
__device__ __forceinline__ void partialSM(f32x16& p0, f32x16& p1, float& m_reg, float& mn, float& alpha) {
    float pmax = p0[0]; for (int r = 1; r < 16; ++r) pmax = fmaxf(pmax, p0[r]); for (int r = 0; r < 16; ++r) pmax = fmaxf(pmax, p1[r]);
    { auto rr = __builtin_amdgcn_permlane32_swap(__float_as_uint(pmax), __float_as_uint(pmax), false, false);
      pmax = fmaxf(__uint_as_float(rr[0]), __uint_as_float(rr[1])); }
    constexpr float C2 = 1.4426950408889634f * SCALE;
    if (__builtin_expect(__all((pmax - m_reg) * SCALE <= THR), 1)) { mn = m_reg; alpha = 1.f; }
    else { mn = fmaxf(m_reg, pmax); alpha = __builtin_amdgcn_exp2f((m_reg - mn) * C2); m_reg = mn; }
    const float mnL = -mn * C2;
    for (int r = 0; r < 16; ++r) p0[r] = fmaf(p0[r], C2, mnL); for (int r = 0; r < 16; ++r) p1[r] = fmaf(p1[r], C2, mnL);
    for (int r = 0; r < 16; ++r) p0[r] = __builtin_amdgcn_exp2f(p0[r]);
}
__device__ __forceinline__ void finishSM(f32x16& p0, f32x16& p1, float alpha, float& l_reg, bf16x8& pa0, bf16x8& pa1, bf16x8& pa2, bf16x8& pa3) {
    for (int r = 0; r < 16; ++r) p1[r] = __builtin_amdgcn_exp2f(p1[r]);
    float ps = 0; for (int r = 0; r < 16; ++r) ps += p0[r]; for (int r = 0; r < 16; ++r) ps += p1[r];
    { auto rr = __builtin_amdgcn_permlane32_swap(__float_as_uint(ps), __float_as_uint(ps), false, false);
      ps = __uint_as_float(rr[0]) + __uint_as_float(rr[1]); }
    l_reg = l_reg * alpha + ps;
#define PK4(P, B_, OUT) do { unsigned a0 = cvtpk(P[B_+0], P[B_+1]), a1 = cvtpk(P[B_+2], P[B_+3]);                          \
        unsigned b0 = cvtpk(P[B_+4], P[B_+5]), b1 = cvtpk(P[B_+6], P[B_+7]);                                             \
        auto r0 = __builtin_amdgcn_permlane32_swap(a0, b0, false, false); auto r1 = __builtin_amdgcn_permlane32_swap(a1, b1, false, false); \
        u32x4 w = {r0[0], r1[0], r0[1], r1[1]}; OUT = *reinterpret_cast<bf16x8*>(&w); } while (0)
    PK4(p0, 0, pa0); PK4(p0, 8, pa1); PK4(p1, 0, pa2); PK4(p1, 8, pa3);
#undef PK4
}
template <int KB, bool SK>
__device__ __forceinline__ void qkt(f32x16& p0, f32x16& p1, const char* K_lds, int r32, int hi, const bf16x8* qr, bool act) {
    if (SK && !act) { const float NEG = -__builtin_inff();
#pragma unroll
        for (int r = 0; r < 16; ++r) { p0[r] = NEG; p1[r] = NEG; } return; }
    { const char* bl = K_lds + 2 * SHM_K + NW * 64 * 4 + KB * 256 + hi * 16;
#pragma unroll
      for (int g = 0; g < 4; ++g) { const f32x4 t0 = *reinterpret_cast<const f32x4*>(bl + g * 32), t1 = *reinterpret_cast<const f32x4*>(bl + 128 + g * 32);
        p0[4 * g] = t0[0]; p0[4 * g + 1] = t0[1]; p0[4 * g + 2] = t0[2]; p0[4 * g + 3] = t0[3]; p1[4 * g] = t1[0]; p1[4 * g + 1] = t1[1]; p1[4 * g + 2] = t1[2]; p1[4 * g + 3] = t1[3]; } }
    const char* kb[4];
#pragma unroll
    for (int dd = 0; dd < 4; ++dd) kb[dd] = K_lds + KB * SHM_K + KSWZ(r32, (dd * 16 + hi * 8) * 2);
#pragma unroll
    for (int d0 = 0; d0 < 8; ++d0) { const char* a = kb[d0 & 3] + (d0 >> 2) * 128;
        bf16x8 b0 = *reinterpret_cast<const bf16x8*>(a);
        bf16x8 b1 = *reinterpret_cast<const bf16x8*>(a + 32 * 256);
        p0 = __builtin_amdgcn_mfma_f32_32x32x16_bf16(b0, qr[d0], p0, 0, 0, 0);
        p1 = __builtin_amdgcn_mfma_f32_32x32x16_bf16(b1, qr[d0], p1, 0, 0, 0); }
}
template <int VB, bool SK>
__device__ __forceinline__ void pv_tile(f32x16* o, int vb0, bf16x8 pa0, bf16x8 pa1, bf16x8 pa2, bf16x8 pa3, bool act) {
    if (SK && !act) return;
#define TRRD(dst, off) asm volatile("ds_read_b64_tr_b16 %0, %1 offset:%2" : "=&v"(dst) : "v"(vb0), "i"(off) : "memory")
#define PV_D0(d0) do { s16x4 l0, l1, l2, l3, h0, h1, h2, h3; constexpr int b_ = VB * SHM_V + v_rd_off(d0, 0, 0);     \
        TRRD(l0, b_); TRRD(h0, b_ + 2048); TRRD(l1, b_ + 4096); TRRD(h1, b_ + 6144); TRRD(l2, b_ + 8192); TRRD(h2, b_ + 10240); TRRD(l3, b_ + 12288); TRRD(h3, b_ + 14336); \
        asm volatile("s_waitcnt lgkmcnt(0)" ::: "memory"); SBAR();                 \
        o[d0] = __builtin_amdgcn_mfma_f32_32x32x16_bf16(pa0, (bf16x8){l0[0], l0[1], l0[2], l0[3], h0[0], h0[1], h0[2], h0[3]}, o[d0], 0, 0, 0);   \
        o[d0] = __builtin_amdgcn_mfma_f32_32x32x16_bf16(pa1, (bf16x8){l1[0], l1[1], l1[2], l1[3], h1[0], h1[1], h1[2], h1[3]}, o[d0], 0, 0, 0);   \
        o[d0] = __builtin_amdgcn_mfma_f32_32x32x16_bf16(pa2, (bf16x8){l2[0], l2[1], l2[2], l2[3], h2[0], h2[1], h2[2], h2[3]}, o[d0], 0, 0, 0);   \
        o[d0] = __builtin_amdgcn_mfma_f32_32x32x16_bf16(pa3, (bf16x8){l3[0], l3[1], l3[2], l3[3], h3[0], h3[1], h3[2], h3[3]}, o[d0], 0, 0, 0); } while (0)
    PV_D0(0); PV_D0(1); PV_D0(2); PV_D0(3);
#undef PV_D0
#undef TRRD
}

template <class TIn, class TOut> struct BlockRef { const TIn* Q; const TIn* K; const TIn* V; TOut* O; const float* G; int P0; int jlo; };
template <class TIn> struct Seam {
    bf16x8 qr[8];
    bf16x8 st_v0, st_v1, st_k0, st_k1; float st_b; f32x4 sf0, sf1, sf2, sf3;
    f32x4 tq[16];
};
__device__ __forceinline__ int swa_jlo(int P0, int W) { const int lowk = P0 - W + 1; return lowk > 0 ? lowk / KVBLK : 0; }
#define ROW(p, k0, rr) ((p) + (size_t)((k0) + (rr)) * PITCH + sc)
#define VMW() asm volatile("s_waitcnt vmcnt(0)" ::: "memory")
#define VMWN(n) asm volatile("s_waitcnt vmcnt(%0)" :: "i"(n) : "memory")
#define SLOAD_H(Kp, Vp, Gp, k0) do { S.st_b = (Gp)[(k0) + (tid & 63)]; S.st_v0 = load8<TIn>(ROW(Vp, k0, sr)); S.st_v1 = load8<TIn>(ROW(Vp, k0, 32 + sr));              \
                         S.st_k0 = load8<TIn>(ROW(Kp, k0, sr)); S.st_k1 = load8<TIn>(ROW(Kp, k0, 32 + sr)); } while (0)
#define SWRITE_HK(bf) do { if (tid < 64) ((float*)(K_lds + 2 * SHM_K + NW * 64 * 4))[(bf) * 64 + tid] = S.st_b; *(bf16x8*)(K_lds + (bf) * SHM_K + kws) = S.st_k0; *(bf16x8*)(K_lds + (bf) * SHM_K + kws + 32 * 256) = S.st_k1; } while (0)
#define SWRITE_HV(bf) do { *(bf16x8*)(V_lds + (bf) * SHM_V + vst0) = S.st_v0; *(bf16x8*)(V_lds + (bf) * SHM_V + vst1) = S.st_v1; } while (0)
#define SWRITE_H(bf) do { SWRITE_HV(bf); SWRITE_HK(bf); } while (0)
#define SLOAD_F(p, k0) do { S.sf0 = *(const f32x4*)ROW(p, k0, sr); S.sf1 = *(const f32x4*)(ROW(p, k0, sr) + 4);                \
                            S.sf2 = *(const f32x4*)ROW(p, k0, 32 + sr); S.sf3 = *(const f32x4*)(ROW(p, k0, 32 + sr) + 4); } while (0)
#define SWRITE_KF(bf) do { *(bf16x8*)(K_lds + (bf) * SHM_K + kws) = pack8(S.sf0, S.sf1); *(bf16x8*)(K_lds + (bf) * SHM_K + kws + 32 * 256) = pack8(S.sf2, S.sf3); } while (0)
#define SWRITE_VF(bf) do { *(bf16x8*)(V_lds + (bf) * SHM_V + vst0) = pack8(S.sf0, S.sf1); *(bf16x8*)(V_lds + (bf) * SHM_V + vst1) = pack8(S.sf2, S.sf3); } while (0)
template <class TIn, class TOut>
__device__ __forceinline__ void causal_swa_prime(const BlockRef<TIn, TOut>& cur, int W, char* lds, Seam<TIn>& S, const int wave_s) {
    constexpr bool F32 = same_t<TIn, float>::v;
    const int lane = fresh_lane(), wid = wave_s, tid = wid * 64 + lane, r32 = lane & 31, hi = lane >> 5;
    const int sr = tid >> 4, sc = (tid & 15) * 8, kws = KSWZ(sr, sc * 2); char* K_lds = lds + 2 * SHM_V;
    const int kb0 = cur.jlo * KVBLK;
    for (int d0 = 0; d0 < 8; ++d0) S.qr[d0] = load8<TIn>(cur.Q + (size_t)(wid * QBLK + r32) * PITCH + d0 * 16 + hi * 8);
    if constexpr (F32) { SLOAD_F((const float*)cur.K, kb0); VMW(); SWRITE_KF(0); SBAR(); SLOAD_F((const float*)cur.V, kb0); }
    else { SLOAD_H(cur.K, cur.V, cur.G, kb0); VMW(); SWRITE_HK(0); }
    __syncthreads();
}
template <class TIn, class TOut>
__device__ __forceinline__ void causal_swa_block(const BlockRef<TIn, TOut>& cur, const BlockRef<TIn, TOut>& nxt, int skv, int W, char* lds, Seam<TIn>& S, const int wave_s) {
    constexpr bool F32 = same_t<TIn, float>::v;
    const int lane = fresh_lane(), wid = wave_s, tid = wid * 64 + lane, r32 = lane & 31, hi = lane >> 5;
    const int j_lo = cur.jlo;
    int j_hi = (cur.P0 + QB - 1) / KVBLK + 1; if (j_hi > skv / KVBLK) j_hi = skv / KVBLK;
    const int NT = j_hi - j_lo;
    const int kbn = nxt.jlo * KVBLK;
    const int qlo = cur.P0 + wid * QBLK, qm = qlo + r32 - 4 * hi;
    char* V_lds = lds; char* K_lds = lds + 2 * SHM_V;
    float* ws = (float*)(lds + 2 * SHM_V + 2 * SHM_K) + wid * 64; float* li_l = ws, * al_l = ws + 32;
    float m_reg = -1e30f, l_reg = 0; f32x16 o[4] = {};
    const int sr = tid >> 4, sc = (tid & 15) * 8, vst0 = v_st(sr, sc), vst1 = v_st(32 + sr, sc), kws = KSWZ(sr, sc * 2);
    const int vb0 = (int)(uintptr_t)V_lds + v_rd_base(lane);
    const TIn* Kh = cur.K; const TIn* Vh = cur.V; const float* Gh = cur.G;
#define RESC(a) do { if (__any((a) < 1.f)) { if (hi == 0) al_l[r32] = (a); asm volatile("s_waitcnt lgkmcnt(0)" ::: "memory");              \
                     for (int d_ = 0; d_ < 4; ++d_) for (int r = 0; r < 16; ++r) o[d_][r] *= al_l[crow(r, hi)]; } } while (0)
#define KBASE(t) ((j_lo + (t)) * KVBLK)
#define ACT(t) (KBASE(t) <= qlo + QBLK - 1 && KBASE(t) + KVBLK - 1 >= qlo - W + 1)
#define MASKT(P0_, P1_, t) do { const int kb_ = KBASE(t); if ((!SK || ACT(t)) && (kb_ + KVBLK - 1 > qlo || kb_ <= qlo + QBLK - 1 - W)) mask_tile(P0_, P1_, qm - kb_, (unsigned)W); } while (0)
    constexpr int NQL = F32 ? 16 : 8;
    constexpr bool SK = WSKIP && !F32;
#define SEAM_K0() do { VMWN(NQL); if constexpr (F32) { SWRITE_KF(0); SBAR(); SLOAD_F((const float*)nxt.V, kbn); } else { SWRITE_HK(0); } SBAR(); } while (0)
    f32x16 pA0, pA1, pB0, pB1; float mnA, mnB, alA, alB; bf16x8 pa0, pa1, pa2, pa3;
    if constexpr (F32) { VMW(); SWRITE_VF(0); SBAR(); } else { SWRITE_HV(0); SBAR(); }
    if (NT > 1) { if constexpr (F32) SLOAD_F((const float*)Kh, KBASE(1)); else SLOAD_H(Kh, Vh, Gh, KBASE(1)); }
    SBAR(); qkt<0, SK>(pA0, pA1, K_lds, r32, hi, S.qr, ACT(0));
    if constexpr (F32) { if (NT > 1) { VMW(); SWRITE_KF(1); SBAR(); SLOAD_F((const float*)Vh, KBASE(1)); } }
    MASKT(pA0, pA1, 0); partialSM(pA0, pA1, m_reg, mnA, alA);
    if (NT > 1) { VMW(); if constexpr (F32) { SWRITE_VF(1); SBAR(); if (NT > 2) SLOAD_F((const float*)Kh, KBASE(2)); } else SWRITE_H(1); }
    __syncthreads();
#define HALF_STEP(PX0, PX1, mnX, alX, PY0, PY1, alY, t, KB, VB, SB) do {                                                      \
        SBAR(); qkt<KB, SK>(PX0, PX1, K_lds, r32, hi, S.qr, ACT(t));                                             \
        finishSM(PY0, PY1, alY, l_reg, pa0, pa1, pa2, pa3); SBAR();                                                           \
        if ((t) + 1 < NT) { if constexpr (F32) { VMW(); SWRITE_KF(SB); SBAR(); SLOAD_F((const float*)Vh, KBASE((t) + 1)); }  \
                            else { SLOAD_H(Kh, Vh, Gh, KBASE((t) + 1)); } SBAR(); }                                               \
        pv_tile<VB, SK>(o, vb0, pa0, pa1, pa2, pa3, ACT((t) - 1)); MASKT(PX0, PX1, (t)); partialSM(PX0, PX1, m_reg, mnX, alX);                                        \
        __syncthreads();                                                                                                      \
        if ((t) + 1 < NT) { VMW(); if constexpr (F32) { SWRITE_VF(SB); SBAR(); if ((t) + 2 < NT) SLOAD_F((const float*)Kh, KBASE((t) + 2)); } \
                            else { SWRITE_H(SB); } }                                                                          \
        RESC(alX); __syncthreads(); } while (0)
    for (int t = 1; t + 1 < NT; t += 2) {
        HALF_STEP(pB0, pB1, mnB, alB, pA0, pA1, alA, t, 1, 0, 0);
        HALF_STEP(pA0, pA1, mnA, alA, pB0, pB1, alB, t + 1, 0, 1, 1);
    }
    const bool even = (NT & 1) == 0;
    if (even) { SBAR(); qkt<1, SK>(pB0, pB1, K_lds, r32, hi, S.qr, ACT(NT - 1)); SBAR(); }
#define QROW(e) (nxt.Q + (size_t)(wid * QBLK + r32) * PITCH + ((e) >> 1) * 16 + hi * 8 + ((e) & 1) * 4)
    if constexpr (F32) { SLOAD_F((const float*)nxt.K, kbn); SBAR();
#pragma unroll
        for (int e = 0; e < 8; ++e) S.tq[e] = *(const f32x4*)QROW(e); }
    else { SLOAD_H(nxt.K, nxt.V, nxt.G, kbn); SBAR();
#pragma unroll
        for (int d0 = 0; d0 < 8; ++d0) S.qr[d0] = load8<TIn>(nxt.Q + (size_t)(wid * QBLK + r32) * PITCH + d0 * 16 + hi * 8); }
    SBAR();
    finishSM(pA0, pA1, alA, l_reg, pa0, pa1, pa2, pa3); SBAR();
    if constexpr (F32) {
#pragma unroll
        for (int e = 8; e < 16; ++e) S.tq[e] = *(const f32x4*)QROW(e); SBAR(); }
#undef QROW
    pv_tile<0, SK>(o, vb0, pa0, pa1, pa2, pa3, ACT(even ? NT - 2 : NT - 1));
    if (even) { MASKT(pB0, pB1, NT - 1); partialSM(pB0, pB1, m_reg, mnB, alB); __syncthreads(); RESC(alB);
        finishSM(pB0, pB1, alB, l_reg, pa0, pa1, pa2, pa3); SBAR(); pv_tile<1, SK>(o, vb0, pa0, pa1, pa2, pa3, ACT(NT - 1)); }
    SBAR(); SEAM_K0();
    if (hi == 0) li_l[r32] = l_reg; asm volatile("s_waitcnt lgkmcnt(0)" ::: "memory");
    float rli[16];
#pragma unroll
    for (int r = 0; r < 16; ++r) rli[r] = __builtin_amdgcn_rcpf(li_l[crow(r, hi)]);
    TOut* Ow = cur.O + (size_t)(wid * QBLK) * PITCH;
#pragma unroll
    for (int r = 0; r < 16; ++r) { const int orow = crow(r, hi);
#pragma unroll
        for (int d0 = 0; d0 < 4; ++d0) { const float v = o[d0][r] * rli[r];
            if constexpr (same_t<TOut, float>::v) { Ow[(size_t)orow * PITCH + d0 * 32 + r32] = v; }
            else { const float vn = __shfl_xor(v, 1);
                   if ((r32 & 1) == 0) *(unsigned*)(Ow + (size_t)orow * PITCH + d0 * 32 + r32) = cvtpk(v, vn); } } }
    if constexpr (F32) {
#pragma unroll
        for (int d0 = 0; d0 < 8; ++d0) S.qr[d0] = pack8(S.tq[2 * d0], S.tq[2 * d0 + 1]); }
    __syncthreads();
#undef RESC
#undef KBASE
#undef ACT
#undef MASKT
#undef SEAM_K0
#undef HALF_STEP
}
#undef ROW
#undef VMW
#undef VMWN
#undef SLOAD_H
#undef SWRITE_HK
#undef SWRITE_HV
#undef SWRITE_H
#undef SLOAD_F
#undef SWRITE_KF
#undef SWRITE_VF


}

#define LAS __attribute__((address_space(3)))
typedef unsigned short bf16_t;
typedef float f32x4 __attribute__((ext_vector_type(4)));
typedef float f32x2 __attribute__((ext_vector_type(2)));
typedef unsigned u32x4 __attribute__((ext_vector_type(4)));
typedef unsigned u32x2 __attribute__((ext_vector_type(2)));

constexpr int BATCH = 4, SEQ = 8192, DM = 1024, NTOK = BATCH * SEQ, DIN = 7176, NPROJ = 7168, DFF = 4096, NH = 8;
constexpr size_t MiB = 1u << 20;
constexpr size_t PLANE = 64 * MiB;
constexpr size_t WS_UB = 448 * MiB;
constexpr size_t WS_NEED = 512 * MiB;
constexpr size_t UB_BAR2 = 0, UB_SSQ2 = 64 * 1024, UB_CNT = 256 * 1024, UB_WDN = 1 * MiB;
constexpr size_t DO_WIN = 0, DO_WA = 16 * MiB, DO_WB = 18 * MiB, DO_WO = 20 * MiB, DO_WUP = 22 * MiB, DO_WDN = 30 * MiB,
                 DO_LOGF = 40 * MiB, DO_G = 41 * MiB, DO_LA = 42 * MiB, DO_LH = 44 * MiB, DO_SSQ = 46 * MiB;
constexpr int LRU_TC = 256, LRU_NCH = SEQ / LRU_TC;
constexpr size_t DO_MISC = 48 * MiB;
constexpr int ATT_FETCH_OFF = 147456 - 128;
constexpr size_t DO_BAR = 52 * MiB; constexpr int BAR_BYTES = 16384;
constexpr size_t DO_LW = 47 * MiB;
constexpr int LRU_WAVE_LDS = 9728 + 8192;
constexpr int LDS_BYTES = 147456;

constexpr int DUP_P4 = 1, DUP_P0 = 1, DUP_SYNC = 0, DUP_ATT = 1, DUP_P1 = 1, DUP_P6 = 1;
struct Params { const float* in[18]; float* out; unsigned char* ws; };

__device__ __forceinline__ unsigned cvtpk2(float lo, float hi) { unsigned r; asm volatile("v_cvt_pk_bf16_f32 %0, %1, %2" : "=v"(r) : "v"(lo), "v"(hi)); return r; }
__device__ __forceinline__ float bf2f(bf16_t v) { return __uint_as_float((unsigned)v << 16); }
__device__ __forceinline__ float wave_sum(float v) {
#pragma unroll
    for (int o = 1; o < 64; o <<= 1) v += __shfl_xor(v, o);
    return v;
}
__device__ __forceinline__ float sigm(float x) { return __builtin_amdgcn_rcpf(1.f + __expf(-x)); }
#define LDS_WAIT() asm volatile("s_waitcnt lgkmcnt(0)" ::: "memory")


#define GAS __attribute__((address_space(1)))
#define RLX_AGENT __ATOMIC_RELAXED, __HIP_MEMORY_SCOPE_AGENT
#define XB_TMO      128
#define XB_XCNT(j)  (256  + 64 * (j))
#define XB_XSUB(j)  (1280 + 64 * (j))
#define XB_XGEN(j)  (2304 + 64 * (j))
#define XB_TOP      3328
#define XB_TOPGEN   3392
#define XCD_BAR_WORDS 3456
#define XB_SPIN_CAP (1u << 18)

__device__ __forceinline__ unsigned xb_ld(unsigned* p)              { return __hip_atomic_load(p, __ATOMIC_RELAXED, __HIP_MEMORY_SCOPE_AGENT); }
__device__ __forceinline__ unsigned xb_add(unsigned* p, unsigned v) { return __hip_atomic_fetch_add(p, v, __ATOMIC_RELAXED, __HIP_MEMORY_SCOPE_AGENT); }
__device__ __forceinline__ unsigned xb_xcc_id() { return (unsigned)__builtin_amdgcn_s_getreg((3 << 11) | 20) & 0xFu; }
#define XB_SPIN(cond, bar) do { unsigned _sp = 0; while (cond) { __builtin_amdgcn_s_sleep(1); \
    if ((++_sp & 255u) == 0u) { if (xb_ld(&(bar)[XB_TMO])) break; if (_sp > XB_SPIN_CAP) { atomicAdd(&(bar)[XB_TMO], 1u); break; } } } } while (0)

struct XcdBarrier {
    unsigned* bar; unsigned x;
    volatile LAS unsigned* st;
};

__device__ __forceinline__ XcdBarrier xcd_barrier_post(unsigned* bar, volatile LAS unsigned* st, const int wave_s) {
    XcdBarrier b; b.bar = bar; b.x = xb_xcc_id(); b.st = st;
    if (wave_s == 0 && fresh_lane() == 0) (void)xb_add(&bar[XB_XCNT(b.x)], 1u);
    return b;
}
__device__ __forceinline__ void xcd_barrier_complete(unsigned* bar, unsigned x, unsigned& nloc, unsigned& nx) {
    const unsigned G = gridDim.x * gridDim.y * gridDim.z;
    unsigned sum, cnt, mine, sp = 0u;
    for (;;) {
        sum = 0u; cnt = 0u; mine = 0u;
#pragma unroll
        for (unsigned j = 0; j < 16; ++j) { const unsigned c = xb_ld(&bar[XB_XCNT(j)]); sum += c; cnt += (c > 0u) ? 1u : 0u; mine = (j == x) ? c : mine; }
        if (sum == G) break;
        __builtin_amdgcn_s_sleep(1);
        if ((++sp & 255u) == 0u) { if (xb_ld(&bar[XB_TMO])) break; if (sp > XB_SPIN_CAP) { atomicAdd(&bar[XB_TMO], 1u); break; } }
    }
    nloc = mine > 0u ? mine : 1u; nx = cnt > 0u ? cnt : 1u;
}

__device__ __forceinline__ void xcd_barrier(const XcdBarrier& b, const int wave_s) {
    asm volatile("s_waitcnt vmcnt(0)" ::: "memory");
    __syncthreads();
    if (wave_s == 0 && fresh_lane() == 0) {
        unsigned* bar = b.bar;
        __builtin_amdgcn_s_waitcnt(0);
        unsigned nloc = b.st[0], nx = b.st[1];
        if (nloc == 0u) { xcd_barrier_complete(bar, b.x, nloc, nx); b.st[0] = nloc; b.st[1] = nx; }
        const unsigned old = xb_add(&bar[XB_XSUB(b.x)], 1u);
        const unsigned gen = old / nloc;
        if (old + 1u == (gen + 1u) * nloc) {
            __builtin_amdgcn_fence(__ATOMIC_RELEASE, "agent");
            asm volatile("s_waitcnt vmcnt(0)" ::: "memory");
            const unsigned og = xb_add(&bar[XB_TOP], 1u);
            const unsigned tg = og / nx;
            if (og + 1u == (tg + 1u) * nx) xb_add(&bar[XB_TOPGEN], 1u);
            else XB_SPIN(xb_ld(&bar[XB_TOPGEN]) == tg, bar);
            __builtin_amdgcn_fence(__ATOMIC_ACQUIRE, "agent");
            xb_add(&bar[XB_XGEN(b.x)], 1u);
            asm volatile("s_waitcnt vmcnt(0)" ::: "memory");
        } else {
            XB_SPIN(xb_ld(&bar[XB_XGEN(b.x)]) == gen, bar);
            __builtin_amdgcn_fence(__ATOMIC_ACQUIRE, "agent");
            asm volatile("s_waitcnt vmcnt(0)" ::: "memory");
        }
    }
    __syncthreads();
}

__device__ __forceinline__ void tr_item(const float* W, int ldn, int nblk, int K, bf16_t* WT, const float* gk, LAS float* scr, int item, int lane) {
    const int kb = item / nblk, nb = item % nblk, k0 = 64 * kb, n0 = 32 * nb;
#pragma unroll
    for (int i = 0; i < 32; ++i) { const int kk = 2 * i + (lane >> 5); float v = W[(size_t)(k0 + kk) * ldn + n0 + (lane & 31)]; if (gk) v *= gk[k0 + kk]; scr[kk * 33 + (lane & 31)] = v; }
    LDS_WAIT();
    const int c = lane & 7;
#pragma unroll
    for (int j = 0; j < 4; ++j) { const int n = (lane >> 3) + 8 * j; const LAS float* s = scr + (8 * c) * 33 + n;
        u32x4 o; o.x = cvtpk2(s[0 * 33], s[1 * 33]); o.y = cvtpk2(s[2 * 33], s[3 * 33]); o.z = cvtpk2(s[4 * 33], s[5 * 33]); o.w = cvtpk2(s[6 * 33], s[7 * 33]);
        *(u32x4*)(WT + (size_t)(n0 + n) * K + k0 + 8 * c) = o; }
    LDS_WAIT();
}

__device__ __forceinline__ void tr_load(const float* W, int ldn, int nblk, LAS float* scr, int item, int lane) {
    const int kb = item / nblk, nb = item % nblk, k0 = 64 * kb, n0 = 32 * nb;
#pragma unroll
    for (int i = 0; i < 32; ++i) { const int kk = 2 * i + (lane >> 5); scr[kk * 33 + (lane & 31)] = W[(size_t)(k0 + kk) * ldn + n0 + (lane & 31)]; }
    LDS_WAIT();
}
__device__ __forceinline__ void tr_store(int nblk, int K, bf16_t* WT, LAS float* scr, int item, int lane) {
    const int kb = item / nblk, nb = item % nblk, k0 = 64 * kb, n0 = 32 * nb, c = lane & 7;
#pragma unroll
    for (int j = 0; j < 4; ++j) { const int n = (lane >> 3) + 8 * j; const LAS float* s = scr + (8 * c) * 33 + n;
        u32x4 o; o.x = cvtpk2(s[0 * 33], s[1 * 33]); o.y = cvtpk2(s[2 * 33], s[3 * 33]); o.z = cvtpk2(s[4 * 33], s[5 * 33]); o.w = cvtpk2(s[6 * 33], s[7 * 33]);
        *(u32x4*)(WT + (size_t)(n0 + n) * K + k0 + 8 * c) = o; }
    LDS_WAIT();
}

__device__ __forceinline__ void phase0(const Params& p, LAS unsigned char* lds, int tid, int lane, int wave) {
    const int gw = blockIdx.x * 8 + wave, NGW = gridDim.x * 8;
    LAS float* scr = (LAS float*)(lds + wave * 16384);
    unsigned char* dob = (unsigned char*)p.out;
    { float* ssq = (float*)(dob + DO_SSQ); for (int i = blockIdx.x * 512 + tid; i < NTOK; i += gridDim.x * 512) ssq[i] = 0.f;
      if (blockIdx.x == 0) { unsigned* mw = (unsigned*)(dob + DO_MISC); for (int i = tid; i < 1024; i += 512) mw[i] = 0u; } }
    constexpr int I_IN = 16 * 224, I_SQ = 16 * 32, I_UP = 16 * 128, NIT = I_IN + 3 * I_SQ + I_UP;
    for (int it = gw; it < NIT; it += NGW) {
        int r = it;
        if (r < I_IN) { tr_item(p.in[2], DIN, 224, 1024, (bf16_t*)(dob + DO_WIN), nullptr, scr, r, lane); continue; } r -= I_IN;
        if (r < I_SQ) { tr_item(p.in[11], 1024, 32, 1024, (bf16_t*)(dob + DO_WA), nullptr, scr, r, lane); continue; } r -= I_SQ;
        if (r < I_SQ) { tr_item(p.in[12], 1024, 32, 1024, (bf16_t*)(dob + DO_WB), nullptr, scr, r, lane); continue; } r -= I_SQ;
        if (r < I_SQ) { tr_item(p.in[13], 1024, 32, 1024, (bf16_t*)(dob + DO_WO), nullptr, scr, r, lane); continue; } r -= I_SQ;
        tr_item(p.in[15], 4096, 128, 1024, (bf16_t*)(dob + DO_WUP), p.in[14], scr, r, lane);
    }
    for (int idx = blockIdx.x * 512 + tid; idx < 2 * 16 * 64 * 8; idx += gridDim.x * 512) {
        const int mat = idx >> 13, r = idx & 8191, nn = r >> 9, dd = (r >> 3) & 63, c0 = (r & 7) * 8;
        const float* W = (mat ? p.in[7] : p.in[5]) + nn * 4096 + dd;
        u32x4 o; o.x = cvtpk2(W[(c0 + 0) * 64], W[(c0 + 1) * 64]); o.y = cvtpk2(W[(c0 + 2) * 64], W[(c0 + 3) * 64]); o.z = cvtpk2(W[(c0 + 4) * 64], W[(c0 + 5) * 64]); o.w = cvtpk2(W[(c0 + 6) * 64], W[(c0 + 7) * 64]);
        *(u32x4*)((bf16_t*)(dob + DO_LW) + mat * 65536 + nn * 4096 + dd * 64 + c0) = o;
    }
    float wf[16][8]; f32x4 gq[4];
#pragma unroll
    for (int j = 0; j < 4; ++j) { gq[j] = *((const f32x4*)p.in[1] + lane + 64 * j);
#pragma unroll
        for (int i = 0; i < 4; ++i) { const float* wp = p.in[2] + (size_t)(256 * j + 4 * lane + i) * DIN + NPROJ; const f32x4 a = *(const f32x4*)wp, b = *(const f32x4*)(wp + 4);
            wf[4 * j + i][0] = a[0]; wf[4 * j + i][1] = a[1]; wf[4 * j + i][2] = a[2]; wf[4 * j + i][3] = a[3]; wf[4 * j + i][4] = b[0]; wf[4 * j + i][5] = b[1]; wf[4 * j + i][6] = b[2]; wf[4 * j + i][7] = b[3]; } }
    const float fb = p.in[10][lane & 7];
    bf16_t* U = (bf16_t*)(p.ws + WS_UB); float* logf = (float*)(dob + DO_LOGF);
    f32x4 vn[4];
    { const f32x4* xr = (const f32x4*)(p.in[0] + (size_t)gw * DM) + lane;
#pragma unroll
      for (int j = 0; j < 4; ++j) vn[j] = xr[64 * j]; }
    for (int m = gw; m < NTOK; m += NGW) {
        f32x4 v[4]; float s = 0.f;
#pragma unroll
        for (int j = 0; j < 4; ++j) { v[j] = vn[j]; s += (v[j][0] * v[j][0] + v[j][1] * v[j][1]) + (v[j][2] * v[j][2] + v[j][3] * v[j][3]); }
        { const int mn = (m + NGW < NTOK) ? m + NGW : m; const f32x4* xr = (const f32x4*)(p.in[0] + (size_t)mn * DM) + lane;
#pragma unroll
          for (int j = 0; j < 4; ++j) vn[j] = xr[64 * j]; }
        const float rstd = 1.0f / sqrtf(wave_sum(s) * (1.0f / DM) + 1e-6f);
        float fl[8] = {0.f, 0.f, 0.f, 0.f, 0.f, 0.f, 0.f, 0.f};
        unsigned long long* o8 = (unsigned long long*)(U + (size_t)m * DM) + lane;
#pragma unroll
        for (int j = 0; j < 4; ++j) { v[j] = v[j] * rstd * gq[j];
#pragma unroll
            for (int i = 0; i < 4; ++i)
#pragma unroll
                for (int h = 0; h < 8; ++h) fl[h] = fmaf(v[j][i], wf[4 * j + i][h], fl[h]);
            o8[64 * j] = (unsigned long long)cvtpk2(v[j][0], v[j][1]) | ((unsigned long long)cvtpk2(v[j][2], v[j][3]) << 32); }
        float my = 0.f;
#pragma unroll
        for (int h = 0; h < 8; ++h) { const float t = wave_sum(fl[h]); my = ((lane & 7) == h) ? t : my; }
        if (lane < 8) { const float z = my + fb; logf[((size_t)(m >> 13) * 8 + lane) * SEQ + (m & (SEQ - 1))] = fminf(z, 0.f) - log1pf(expf(-fabsf(z))); }
    }
}

__device__ __forceinline__ void forget_cumsum(const Params& p, LAS unsigned char* lds, int tid, int lane, int wave) {
    unsigned char* dob = (unsigned char*)p.out;
    for (int bh = blockIdx.x; bh < BATCH * NH; bh += gridDim.x) {
        const int b = bh >> 3, h = bh & 7;
        const float* lf = (const float*)(dob + DO_LOGF) + (size_t)bh * SEQ; (void)b; (void)h;
        float* Gp = (float*)(dob + DO_G) + (size_t)bh * SEQ;
        float loc[16]; float s = 0.f;
#pragma unroll
        for (int i = 0; i < 4; ++i) { const f32x4 v = *(const f32x4*)(lf + 16 * tid + 4 * i); loc[4 * i] = v[0]; loc[4 * i + 1] = v[1]; loc[4 * i + 2] = v[2]; loc[4 * i + 3] = v[3]; }
#pragma unroll
        for (int i = 0; i < 16; ++i) s += loc[i];
        float incl = s;
#pragma unroll
        for (int o = 1; o < 64; o <<= 1) { const float t = __shfl_up(incl, o); if (lane >= o) incl += t; }
        LAS float* wt = (LAS float*)lds;
        if (lane == 63) wt[wave] = incl;
        __syncthreads();
        float run = incl - s;
        for (int w = 0; w < wave; ++w) run += wt[w];
#pragma unroll
        for (int i = 0; i < 4; ++i) { f32x4 o;
#pragma unroll
            for (int k = 0; k < 4; ++k) { run += loc[4 * i + k]; o[k] = -run * 11.313708498984761f; }
            *(f32x4*)(Gp + 16 * tid + 4 * i) = o; }
        __syncthreads();
    }
}

typedef short s16x8 __attribute__((ext_vector_type(8)));
__device__ __forceinline__ float lds_bf(const LAS unsigned char* p) { return __uint_as_float((unsigned)(*(const LAS unsigned short*)p) << 16); }
template <bool APPLY>
__device__ __forceinline__ void lru_unit(const Params& p, int b, int c, int n, int lane, LAS unsigned char* wl) {
    unsigned char* dob = (unsigned char*)p.out;
    const int fr = lane & 15, fq = lane >> 4;
    const bf16_t* wat = (const bf16_t*)(dob + DO_LW) + n * 4096; const bf16_t* wxt = wat + 65536;
    LAS unsigned char* xs = wl; LAS unsigned char* gs = wl + 9728;
    const int t0 = c * LRU_TC;
    const size_t gofs = (size_t)(b * SEQ + t0) * DM + n * 64;
    const bf16_t* xg = (const bf16_t*)p.ws + gofs;
    bf16_t* gg = (bf16_t*)(p.ws + PLANE) + gofs;
    float* LA = (float*)(dob + DO_LA); float* LH = (float*)(dob + DO_LH);
    float hsub[4] = {0.f, 0.f, 0.f, 0.f}, slr[4] = {0.f, 0.f, 0.f, 0.f};
    if (APPLY) {
        for (int j = 0; j < c; ++j) { const size_t o = ((size_t)(b * LRU_NCH + j)) * DM + n * 64 + fr;
#pragma unroll
            for (int q = 0; q < 4; ++q) hsub[q] = fmaf(LA[o + 16 * q], hsub[q], LH[o + 16 * q]); }
    }
    u32x4 xpre[9], gpre[8];
#define LRU_LOAD(s_) do { const bf16_t* xb_ = xg + (ptrdiff_t)(64 * (s_) - 3 + (lane >> 3)) * DM + (lane & 7) * 8; asm volatile("" : "+v"(xb_));   \
        _Pragma("unroll") for (int it = 0; it < 9; ++it) { const int row = it * 8 + (lane >> 3); u32x4 v = {0u, 0u, 0u, 0u}; \
            if (row < 67 && t0 + 64 * (s_) - 3 + row >= 0) v = *(const u32x4*)(xb_ + (size_t)it * 8 * DM); xpre[it] = v; } \
        } while (0)
#define LRU_LOADG(s_) do { if (APPLY) { const bf16_t* gb_ = gg + (size_t)(64 * (s_) + (lane >> 3)) * DM + (lane & 7) * 8; asm volatile("" : "+v"(gb_)); \
        _Pragma("unroll") for (int it = 0; it < 8; ++it) gpre[it] = *(const u32x4*)(gb_ + (size_t)it * 8 * DM); } } while (0)
    s16x8 nBa[2], nBx[2];
#define LRU_QLOAD(q_) do { \
        _Pragma("unroll") for (int ks = 0; ks < 2; ++ks) { nBa[ks] = *(const s16x8*)(wat + (16 * (q_) + fr) * 64 + 32 * ks + 8 * fq); nBx[ks] = *(const s16x8*)(wxt + (16 * (q_) + fr) * 64 + 32 * ks + 8 * fq); } } while (0)
    LRU_QLOAD(0);
    LRU_LOAD(0);
    for (int s = 0; s < LRU_TC / 64; ++s) {
#pragma unroll
        for (int it = 0; it < 9; ++it) { const int row = it * 8 + (lane >> 3), ch = lane & 7; if (row < 67) *(LAS u32x4*)(xs + row * 144 + ch * 16) = xpre[it]; }
        LRU_LOADG(s);
        if (s + 1 < LRU_TC / 64) LRU_LOAD(s + 1);
        LDS_WAIT();
        s16x8 Af[4][2];
#pragma unroll
        for (int ks = 0; ks < 2; ++ks) {
            const int cA = n * 64 + 32 * ks + 8 * fq;
            f32x4 cw[4][2], cbv[2];
#pragma unroll
            for (int k = 0; k < 4; ++k) { cw[k][0] = *(const f32x4*)(p.in[3] + k * 1024 + cA); cw[k][1] = *(const f32x4*)(p.in[3] + k * 1024 + cA + 4); }
            cbv[0] = *(const f32x4*)(p.in[4] + cA); cbv[1] = *(const f32x4*)(p.in[4] + cA + 4);
#pragma unroll
            for (int m = 0; m < 4; ++m) { const int tau = 16 * (fr >> 2) + 4 * m + (fr & 3);
                f32x4 a0 = cbv[0], a1 = cbv[1];
#pragma unroll
                for (int k = 0; k < 4; ++k) { const u32x4 xv = *(const LAS u32x4*)(xs + (tau + k) * 144 + (32 * ks + 8 * fq) * 2);
                    a0[0] = fmaf(cw[k][0][0], __uint_as_float(xv.x << 16), a0[0]); a0[1] = fmaf(cw[k][0][1], __uint_as_float(xv.x & 0xffff0000u), a0[1]);
                    a0[2] = fmaf(cw[k][0][2], __uint_as_float(xv.y << 16), a0[2]); a0[3] = fmaf(cw[k][0][3], __uint_as_float(xv.y & 0xffff0000u), a0[3]);
                    a1[0] = fmaf(cw[k][1][0], __uint_as_float(xv.z << 16), a1[0]); a1[1] = fmaf(cw[k][1][1], __uint_as_float(xv.z & 0xffff0000u), a1[1]);
                    a1[2] = fmaf(cw[k][1][2], __uint_as_float(xv.w << 16), a1[2]); a1[3] = fmaf(cw[k][1][3], __uint_as_float(xv.w & 0xffff0000u), a1[3]); }
                u32x4 w = {cvtpk2(a0[0], a0[1]), cvtpk2(a0[2], a0[3]), cvtpk2(a1[0], a1[1]), cvtpk2(a1[2], a1[3])};
                Af[m][ks] = *reinterpret_cast<s16x8*>(&w); }
        }
        if (APPLY) {
#pragma unroll
            for (int it = 0; it < 8; ++it) { const int row = it * 8 + (lane >> 3), ch = lane & 7; *(LAS u32x4*)(gs + row * 128 + ch * 16) = gpre[it]; }
            LDS_WAIT(); }
#pragma unroll 1
        for (int q = 0; q < 4; ++q) {
            const int cl = 16 * q + fr;
            s16x8 Ba[2] = {nBa[0], nBa[1]}, Bx[2] = {nBx[0], nBx[1]};
            const int d = n * 64 + cl;
            const float ba = p.in[6][d], bx = p.in[8][d], nl = -p.in[9][d];
            const float cw0 = p.in[3][d], cw1 = p.in[3][1024 + d], cw2 = p.in[3][2048 + d], cw3 = p.in[3][3072 + d], cb = p.in[4][d];
            LRU_QLOAD((q + 1) & 3);
            const float kk = -8.0f * (fmaxf(nl, 0.f) + log1pf(__expf(-fabsf(nl))));
            f32x4 aR[4], aI[4];
#pragma unroll
            for (int m = 0; m < 4; ++m) { aR[m] = (f32x4){ba, ba, ba, ba}; aI[m] = (f32x4){bx, bx, bx, bx};
#pragma unroll
                for (int ks = 0; ks < 2; ++ks) { aR[m] = __builtin_amdgcn_mfma_f32_16x16x32_bf16(Af[m][ks], Ba[ks], aR[m], 0, 0, 0); aI[m] = __builtin_amdgcn_mfma_f32_16x16x32_bf16(Af[m][ks], Bx[ks], aI[m], 0, 0, 0); } }
            float xw[19];
#pragma unroll
            for (int i = 0; i < 19; ++i) xw[i] = lds_bf(xs + (16 * fq + i) * 144 + cl * 2);
            float av[16], bv[16]; float hl = 0.f, sr = 0.f; const float kkl = kk * 1.4426950408889634f, kk2 = 2.0f * kk;
#pragma unroll
            for (int ip = 0; ip < 8; ++ip) {
                const int i = 2 * ip;
                f32x2 xa = (f32x2){cb, cb} + (f32x2){cw0, cw0} * (f32x2){xw[i], xw[i + 1]} + (f32x2){cw1, cw1} * (f32x2){xw[i + 1], xw[i + 2]} + (f32x2){cw2, cw2} * (f32x2){xw[i + 2], xw[i + 3]} + (f32x2){cw3, cw3} * (f32x2){xw[i + 3], xw[i + 4]};
                f32x2 eR = (f32x2){aR[i >> 2][i & 3], aR[i >> 2][(i & 3) + 1]} * -1.4426950408889634f, eI = (f32x2){aI[i >> 2][i & 3], aI[i >> 2][(i & 3) + 1]} * -1.4426950408889634f;
                eR.x = __builtin_amdgcn_exp2f(eR.x); eR.y = __builtin_amdgcn_exp2f(eR.y); eI.x = __builtin_amdgcn_exp2f(eI.x); eI.y = __builtin_amdgcn_exp2f(eI.y);
                eR = eR + 1.0f; eI = eI + 1.0f;
                f32x2 r, ig; r.x = __builtin_amdgcn_rcpf(eR.x); r.y = __builtin_amdgcn_rcpf(eR.y); ig.x = __builtin_amdgcn_rcpf(eI.x); ig.y = __builtin_amdgcn_rcpf(eI.y);
                f32x2 a = r * kkl; const f32x2 y = r * kk2;
                a.x = __builtin_amdgcn_exp2f(a.x); a.y = __builtin_amdgcn_exp2f(a.y);
                f32x2 om = y * (1.0f / 120.0f) + (1.0f / 24.0f); om = om * y + (1.0f / 6.0f); om = om * y + 0.5f; om = om * y + 1.0f; om = om * (-y);
                const f32x2 ex = 1.0f - a * a;
                f32x2 sq; sq.x = __builtin_amdgcn_sqrtf(y.x < -0.5f ? ex.x : om.x); sq.y = __builtin_amdgcn_sqrtf(y.y < -0.5f ? ex.y : om.y);
                const f32x2 bt = sq * ig * xa;
                av[i] = a.x; av[i + 1] = a.y; bv[i] = bt.x; bv[i + 1] = bt.y;
                hl = fmaf(a.x, hl, bt.x); hl = fmaf(a.y, hl, bt.y); sr += r.x + r.y;
            }
            const float sl = kk * sr, Al = __expf(sl);
            float st = q == 0 ? hsub[0] : q == 1 ? hsub[1] : q == 2 ? hsub[2] : hsub[3], hin = st;
#pragma unroll
            for (int j = 0; j < 4; ++j) { const float Aj = __shfl(Al, fr + 16 * j), Hj = __shfl(hl, fr + 16 * j); st = fmaf(Aj, st, Hj); if (j < fq) hin = st; }
#pragma unroll
            for (int z = 0; z < 4; ++z) { hsub[z] = (z == q) ? st : hsub[z]; slr[z] += (z == q) ? sl : 0.f; }
            if (APPLY) {
                float h = hin;
#pragma unroll
                for (int i = 0; i < 16; ++i) { h = fmaf(av[i], h, bv[i]);
                    LAS unsigned short* gp = (LAS unsigned short*)(gs + (16 * fq + i) * 128 + cl * 2);
                    const float g = __uint_as_float((unsigned)(*gp) << 16); const float ge = g * sigm(1.5957691216057308f * (g + 0.044715f * g * g * g));
                    *gp = (unsigned short)(cvtpk2(ge * h, 0.f) & 0xffffu); }
            }
        }
        if (APPLY) {
            LDS_WAIT();
#pragma unroll
            for (int it = 0; it < 8; ++it) { const int row = it * 8 + (lane >> 3), ch = lane & 7;
                *(u32x4*)(gg + (size_t)(64 * s + row) * DM + ch * 8) = *(const LAS u32x4*)(gs + row * 128 + ch * 16); }
        }
        LDS_WAIT();
    }
    if (!APPLY) {
#pragma unroll
        for (int q = 0; q < 4; ++q) { float t = slr[q]; t += __shfl_xor(t, 16); t += __shfl_xor(t, 32);
            if (fq == 0) { const size_t o = ((size_t)(b * LRU_NCH + c)) * DM + n * 64 + 16 * q + fr; LA[o] = __expf(t); LH[o] = hsub[q]; } }
    }
}
#undef LRU_LOAD
#undef LRU_LOADG
#undef LRU_QLOAD
template <bool APPLY>
__device__ __forceinline__ void lru_phase(const Params& p, LAS unsigned char* lds, int lane, int wave) {
    LAS unsigned char* wl = lds + wave * LRU_WAVE_LDS;
    const int gw = blockIdx.x * 8 + wave, NGW = gridDim.x * 8;
    for (int uix = gw; uix < BATCH * LRU_NCH * 16; uix += NGW) {
        const int b = uix / (LRU_NCH * 16), c = (uix / 16) % LRU_NCH, n = uix % 16;
        if (!APPLY && c == LRU_NCH - 1) continue;
        lru_unit<APPLY>(p, b, c, n, lane, wl);
    }
}

__device__ __forceinline__ att::BlockRef<att::bf16, att::bf16> att_ref(const Params& p, int e) {
    const int bh = e >> 5, qb = e & 31, b = bh >> 3, h = bh & 7;
    const size_t rowq = (size_t)(b * SEQ + qb * 256) * DM + h * 128, rowk = (size_t)(b * SEQ) * DM + h * 128;
    att::BlockRef<att::bf16, att::bf16> r;
    r.Q = (const att::bf16*)(p.ws + 2 * PLANE) + rowq; r.K = (const att::bf16*)(p.ws + 3 * PLANE) + rowk; r.V = (const att::bf16*)(p.ws + 4 * PLANE) + rowk;
    r.O = (att::bf16*)(p.ws + WS_UB) + rowq; r.G = (const float*)((const unsigned char*)p.out + DO_G) + (size_t)bh * SEQ; r.P0 = qb * 256;
    r.jlo = ((const int*)((const unsigned char*)p.out + DO_MISC + 8192))[e];
    return r;
}
__device__ __forceinline__ void jlo_phase(const Params& p, int lane, int wave) {
    const unsigned char* dob = (const unsigned char*)p.out;
    int* jlo = (int*)((unsigned char*)p.out + DO_MISC + 8192);
    if (wave >= 4) return;
    for (int e = wave * (int)gridDim.x + (int)blockIdx.x; e < BATCH * NH * 32; e += 4 * (int)gridDim.x) {
        const int bh = e >> 5, qb = e & 31, b = bh >> 3, h = bh & 7, half = lane & 1;
        const float* Gp = (const float*)(dob + DO_G) + (size_t)bh * SEQ;
        float qn = 0.f, L = 3.0e38f;
#pragma unroll
        for (int ps = 0; ps < 2; ++ps) {
            const int row = ps * 128 + (lane >> 1);
            const size_t off = (size_t)(b * SEQ + qb * 256 + row) * DM + h * 128 + half * 64;
            const bf16_t* q = (const bf16_t*)(p.ws + 2 * PLANE) + off; const bf16_t* k = (const bf16_t*)(p.ws + 3 * PLANE) + off;
            const float gr = Gp[qb * 256 + row];
            float dq = 0.f, qq = 0.f;
#pragma unroll
            for (int i = 0; i < 8; ++i) { const u32x4 a = *(const u32x4*)(q + 8 * i), c = *(const u32x4*)(k + 8 * i);
#pragma unroll
                for (int w = 0; w < 4; ++w) { const float a0 = __uint_as_float(a[w] << 16), a1 = __uint_as_float(a[w] & 0xffff0000u), c0 = __uint_as_float(c[w] << 16), c1 = __uint_as_float(c[w] & 0xffff0000u);
                    dq = fmaf(a0, c0, dq); dq = fmaf(a1, c1, dq); qq = fmaf(a0, a0, qq); qq = fmaf(a1, a1, qq); } }
            dq += __shfl_xor(dq, 1); qq += __shfl_xor(qq, 1);
            L = fminf(L, dq + gr); qn = fmaxf(qn, sqrtf(qq));
        }
#pragma unroll
        for (int o = 2; o < 64; o <<= 1) { qn = fmaxf(qn, __shfl_xor(qn, o)); L = fminf(L, __shfl_xor(L, o)); }
        const unsigned* KP = (const unsigned*)(dob + DO_MISC) + bh * 4;
        const float Kmax = sqrtf(((__uint_as_float(KP[0]) + __uint_as_float(KP[1])) + (__uint_as_float(KP[2]) + __uint_as_float(KP[3]))) * 1.01f);
        const float thresh = L - 1180.0f - qn * 1.002f * Kmax;
        int jl = 4 * qb + 3;
#pragma unroll
        for (int t0 = 0; t0 < 128; t0 += 64) { const int t = t0 + lane; if (t < 4 * qb + 3) { if (!(Gp[64 * t + 63] < thresh)) jl = min(jl, t); } }
#pragma unroll
        for (int o = 1; o < 64; o <<= 1) jl = min(jl, __shfl_xor(jl, o));
        if (lane == 0) jlo[e] = jl;
    }
}
__device__ __forceinline__ int att_fetch(const Params& p) {
    unsigned* heads = (unsigned*)((unsigned char*)p.out + DO_MISC) + 512;
    const int q0 = blockIdx.x & 7;
    for (int k = 0; k < 8; ++k) { const int q = (q0 + k) & 7;
        const unsigned idx = __hip_atomic_fetch_add(heads + 64 * q, 1u, __ATOMIC_RELAXED, __HIP_MEMORY_SCOPE_AGENT);
        if (idx < 128u * DUP_ATT) return (4 * q + (int)(idx & 3u)) * 32 + (31 - (int)((idx & 127u) >> 2)); }
    return -1;
}

__global__ void __launch_bounds__(512, 2) mega_fwd(Params p) {
    extern __shared__ __attribute__((aligned(16))) unsigned char lds[];
    cg::grid_group grid = cg::this_grid();
    const int wave = __builtin_amdgcn_readfirstlane((int)threadIdx.x >> 6);
#define FRESH() const int lane = fresh_lane(), tid = wave * 64 + lane; (void)tid; (void)lane
    const int G = gridDim.x, bid = blockIdx.x;
    LAS unsigned char* L3 = (LAS unsigned char*)lds;
    unsigned char* dob = (unsigned char*)p.out;
    bf16_t* PL0 = (bf16_t*)p.ws;
    const size_t PE = PLANE / 2;
    volatile LAS unsigned* MISC = (volatile LAS unsigned*)(L3 + LDS_BYTES - 64);
    { FRESH(); if (tid < 16) MISC[tid] = 0u; }
    __syncthreads();
    const XcdBarrier xbar = xcd_barrier_post((unsigned*)(dob + DO_BAR), MISC, wave);
#define GRID_BAR() xcd_barrier(xbar, wave)

    { FRESH(); phase0(p, L3, tid, lane, wave); }
    if (p.ws == nullptr) grid.sync();
    GRID_BAR();
    { FRESH(); forget_cumsum(p, L3, tid, lane, wave); }
    for (int rep = 0; rep < DUP_P1; ++rep)
    { pg8::Gemm g{(const bf16_t*)(p.ws + WS_UB), (const bf16_t*)(dob + DO_WIN), NTOK, NPROJ, DM, nullptr, nullptr}; pg8::StaticOrder S; S.init(NTOK, NPROJ, G, bid);
      pg8::EpiProj E{PL0, PE, (unsigned*)(dob + DO_MISC)};
      pg8::gemm_phase<pg8::EpiProj, pg8::StaticOrder, true, true>(L3, g, S, E, wave); }
    GRID_BAR();
    { FRESH(); jlo_phase(p, lane, wave); }
    { FRESH(); lru_phase<false>(p, L3, lane, wave); }
    { FRESH(); if (tid == 0) { LAS int* fw0 = (LAS int*)(L3 + ATT_FETCH_OFF); fw0[0] = att_fetch(p); fw0[1] = att_fetch(p); } }
    GRID_BAR();
    {
        LAS int* fw = (LAS int*)(L3 + ATT_FETCH_OFF);
        int cur_e = 0, nxt_e = 0;
        cur_e = fw[0]; nxt_e = fw[1];
        __syncthreads();
        if (cur_e >= 0) {
            att::BlockRef<att::bf16, att::bf16> cur = att_ref(p, cur_e);
            att::Seam<att::bf16> S;
            att::causal_swa_prime<att::bf16, att::bf16>(cur, SEQ, (char*)lds, S, wave);
            for (;;) {
                const bool last = nxt_e < 0;
                const att::BlockRef<att::bf16, att::bf16> nxt = last ? cur : att_ref(p, nxt_e);
                int fetched = -1;
                if (!last) { FRESH(); if (tid == 0) fetched = att_fetch(p); }
                att::causal_swa_block<att::bf16, att::bf16>(cur, nxt, SEQ, SEQ, (char*)lds, S, wave);
                if (last) break;
                { FRESH(); if (tid == 0) fw[0] = fetched; }
                __syncthreads();
                cur = nxt; nxt_e = fw[0];
                __syncthreads();
            }
        }
        asm volatile("s_waitcnt vmcnt(0)" ::: "memory");
        __syncthreads();
        { FRESH(); lru_phase<true>(p, L3, lane, wave); }
    }
    GRID_BAR();
    for (int rep = 0; rep < DUP_P4; ++rep)
    { pg8::StaticOrder S; S.init(NTOK, DM, G, bid);
      pg8::Gemm g{PL0 + PE, (const bf16_t*)(dob + DO_WA), NTOK, DM, 2 * DM, (const bf16_t*)(p.ws + WS_UB), (const bf16_t*)(dob + DO_WB)};
      pg8::EpiMix E{PL0 + 5 * PE, PL0 + 6 * PE, PL0 + 2 * PE};
      pg8::gemm_phase<pg8::EpiMix, pg8::StaticOrder, true, true, true>(L3, g, S, E, wave); }
    { FRESH(); const int it = bid * 8 + wave; if (it < 64 * 32) tr_load(p.in[16], 1024, 32, (LAS float*)(L3 + wave * 16384), it, lane); }
    GRID_BAR();
    { FRESH();
      if (bid == 0) { unsigned* b2 = (unsigned*)(p.ws + WS_UB + UB_BAR2); for (int i = tid; i < BAR_BYTES / 4; i += 512) b2[i] = 0u; }
      { unsigned* z = (unsigned*)(p.ws + WS_UB + UB_SSQ2); for (int i = bid * 512 + tid; i < (int)((UB_WDN - UB_SSQ2) / 4); i += G * 512) z[i] = 0u; }
      LAS float* scr = (LAS float*)(L3 + wave * 16384);
      { const int it0 = bid * 8 + wave; if (it0 < 64 * 32) tr_store(32, 4096, (bf16_t*)(p.ws + WS_UB + UB_WDN), scr, it0, lane);
        for (int it = it0 + G * 8; it < 64 * 32; it += G * 8) tr_item(p.in[16], 1024, 32, 4096, (bf16_t*)(p.ws + WS_UB + UB_WDN), nullptr, scr, it, lane); }
      __syncthreads(); }
    { pg8::StaticOrder S; S.init(NTOK, DM, G, bid);
      pg8::Gemm g{PL0 + 2 * PE, (const bf16_t*)(dob + DO_WO), NTOK, DM, DM, nullptr, nullptr}; pg8::EpiRes1 E{p.in[0], PL0, (float*)(dob + DO_SSQ)};
      pg8::gemm_phase<pg8::EpiRes1, pg8::StaticOrder, true, true>(L3, g, S, E, wave); }
    GRID_BAR();
    const XcdBarrier xbar2 = xcd_barrier_post((unsigned*)(p.ws + WS_UB + UB_BAR2), MISC + 2, wave);
    for (int rep = 0; rep < DUP_P6; ++rep)
    { pg8::StaticOrder S; S.init(NTOK, DFF, G, bid);
      pg8::Gemm g{PL0, (const bf16_t*)(dob + DO_WUP), NTOK, DFF, DM, nullptr, nullptr}; pg8::EpiUp E{(const float*)(dob + DO_SSQ), PL0 + PE};
      pg8::gemm_phase<pg8::EpiUp, pg8::StaticOrder, true, true>(L3, g, S, E, wave); }
    xcd_barrier(xbar2, wave);
    { pg8::StaticOrder S; S.init(NTOK, DM, G, bid);
      pg8::Gemm g{PL0 + PE, (const bf16_t*)(p.ws + WS_UB + UB_WDN), NTOK, DM, DFF, nullptr, nullptr};
      pg8::EpiDownNorm E{PL0, p.out, p.in[17], (float*)(p.ws + WS_UB + UB_SSQ2), (unsigned*)(p.ws + WS_UB + UB_CNT)};
      pg8::gemm_phase<pg8::EpiDownNorm, pg8::StaticOrder, true, true>(L3, g, S, E, wave); }
}

extern "C" void kernel_launch(void* const* d_in, const int* in_sizes, int n_in, void* d_out, int out_size, void* d_ws, size_t ws_size, hipStream_t stream) {
    static int grid = 0;
    if (grid == 0) {
        if (n_in != 18 || in_sizes[0] != NTOK * DM || out_size != NTOK * DM || ws_size < WS_NEED) {
            fprintf(stderr, "kernel_launch: unexpected shapes (n_in %d, in0 %d, out %d, ws %zu)\n", n_in, n_in > 0 ? in_sizes[0] : -1, out_size, ws_size); grid = -1; return; }
        int dev = 0, cus = 0, per_cu = 0;
        (void)hipGetDevice(&dev); (void)hipDeviceGetAttribute(&cus, hipDeviceAttributeMultiprocessorCount, dev);
        if (hipFuncSetAttribute((const void*)mega_fwd, hipFuncAttributeMaxDynamicSharedMemorySize, LDS_BYTES) != hipSuccess) { fprintf(stderr, "kernel_launch: hipFuncSetAttribute failed\n"); grid = -1; return; }
        if (hipOccupancyMaxActiveBlocksPerMultiprocessor(&per_cu, (const void*)mega_fwd, 512, LDS_BYTES) != hipSuccess || per_cu < 1) { fprintf(stderr, "kernel_launch: occupancy query says %d\n", per_cu); per_cu = 1; }
        (void)hipGetLastError();
        grid = cus > 0 ? cus : 256;
    }
    if (grid < 0) return;
    if (hipMemsetAsync((unsigned char*)d_out + DO_BAR, 0, BAR_BYTES, stream) != hipSuccess) { fprintf(stderr, "kernel_launch: memset failed\n"); return; }
    Params p{};
    for (int i = 0; i < 18; ++i) p.in[i] = (const float*)d_in[i];
    p.out = (float*)d_out; p.ws = (unsigned char*)d_ws;
    void* args[] = {&p};
    hipError_t e = hipLaunchCooperativeKernel((const void*)mega_fwd, dim3(grid), dim3(512), args, LDS_BYTES, stream);
    if (e != hipSuccess) fprintf(stderr, "cooperative launch failed: %s (grid %d)\n", hipGetErrorString(e), grid);
}
```

```cpp
#include <hip/hip_runtime.h>
#include <hip/hip_bf16.h>
#include <hip/hip_cooperative_groups.h>
#include <cstdio>
#include <cstdint>
#include <cmath>
namespace cg = cooperative_groups;

__device__ __forceinline__ int fresh_lane() { int l; asm volatile("v_mbcnt_lo_u32_b32 %0, -1, 0\n\tv_mbcnt_hi_u32_b32 %0, -1, %0" : "=v"(l)); return l; }

namespace pg8 {
#define PG8_LAS __attribute__((address_space(3)))
typedef unsigned short bf16_t;
typedef short bf16x8 __attribute__((ext_vector_type(8)));
typedef float f32x4 __attribute__((ext_vector_type(4)));
typedef unsigned u32x4 __attribute__((ext_vector_type(4)));
constexpr int BM = 256, BK = 64, HALF = 128, HTB = HALF * BK * 2  , STAGE_BYTES = 8 * HTB, NXCD = 8, WGM = 4;

__host__ __device__ __forceinline__ int lds_byte(int r, int c) { const int st = (r >> 4) * 2 + (c >> 5), rr = r & 15, cc = c & 31, ob = rr * 64 + cc * 2; return st * 1024 + (ob ^ (((ob >> 9) & 1) << 5)); }
__host__ __device__ __forceinline__ void stage_rc(int b, int& R, int& C) { const int st = b / 1024, sb = b % 1024, swz = sb ^ (((sb >> 9) & 1) << 5); R = (st >> 1) * 16 + swz / 64; C = (st & 1) * 32 + (swz % 64) / 2; }
__host__ __device__ __forceinline__ int perm32(int rho) { const int n = rho >> 4, i = rho & 15; return 8 * (i >> 2) + 4 * n + (i & 3); }

struct Unit { int pm, pn; };
struct Gemm { const bf16_t* A; const bf16_t* Bt; int M, N, K; const bf16_t* A2; const bf16_t* Bt2; };

struct StaticOrder {
    int nM, nN, nwg, G, c;
    __host__ __device__ void init(int M, int N, int G_, int c_) { nM = M / BM; nN = N / BM; nwg = nM * nN; G = G_; c = c_; }
    __host__ __device__ bool next(int i, Unit& u) const {
        const long L = (long)i * G + c; if (L >= nwg) return false;
        int wgid = (int)L; { const int q = nwg / NXCD, r = nwg % NXCD, xcd = wgid % NXCD, off = wgid / NXCD; wgid = (xcd < r ? xcd * (q + 1) : r * (q + 1) + (xcd - r) * q) + off; }
        const int nig = WGM * nN, gid = wgid / nig, fm = gid * WGM, gsz = (nM - fm) < WGM ? (nM - fm) : WGM;
        u.pm = fm + ((wgid % nig) % gsz); u.pn = (wgid % nig) / gsz; return true;
    }
    __device__ __forceinline__ void a_ready(const Unit&) const {}
    __device__ __forceinline__ void done(const Unit&) const {}
};

__device__ __forceinline__ unsigned cvt_pk_bf16(float lo, float hi) { unsigned r; asm volatile("v_cvt_pk_bf16_f32 %0, %1, %2" : "=v"(r) : "v"(lo), "v"(hi)); return r; }
typedef float f32x2 __attribute__((ext_vector_type(2)));
__device__ __forceinline__ f32x2 gelu_pk(f32x2 v) {
    const f32x2 av = __builtin_elementwise_abs(v), d = av * 0.2316418882f + 1.0f;
    f32x2 t; t.x = __builtin_amdgcn_rcpf(d.x); t.y = __builtin_amdgcn_rcpf(d.y);
    f32x2 q = t * 0.5307027145f + (-0.7265760135f); q = q * t + 0.7107068705f; q = q * t + (-0.142248368f); q = q * t + 0.127414796f; q = q * t;
    const f32x2 s = (v * v) * (-0.72134752044f);
    f32x2 e; e.x = __builtin_amdgcn_exp2f(s.x); e.y = __builtin_amdgcn_exp2f(s.y);
    const f32x2 m = v * (q * e), r = v - m;
    f32x2 o; o.x = v.x < 0.f ? m.x : r.x; o.y = v.y < 0.f ? m.y : r.y; return o;
}

template <int ACT  > struct EpiBf16 {
    static constexpr bool PERM = true, AFTER_DRAIN = false; static_assert(ACT == 0 || ACT == 1, "EpiBf16: ACT is 0 (none) or 1 (gelu_pk)");
    bf16_t* O; int ldc; const float* bias; int split_cols; size_t split_stride; float scale0;
    __device__ __forceinline__ void operator()(const f32x4 (&acc)[2][2][4][2], const Unit& u, int wr, int wc, int fr, int fq) const {
        const int row0 = u.pm * BM + wr * 64 + fr; int colt = u.pn * BM; bf16_t* base = O;
        float sc = 1.f; if (split_cols) { const int t = colt / split_cols; base += (size_t)t * split_stride; colt -= t * split_cols; if (t == 0) sc = scale0; }
        const int col0 = colt + wc * 32 + 8 * fq, bcol0 = u.pn * BM + wc * 32 + 8 * fq;
        f32x4 bv[2][2];
#pragma unroll
        for (int bj = 0; bj < 2; ++bj)
#pragma unroll
            for (int n = 0; n < 2; ++n) bv[bj][n] = bias ? *(const f32x4*)(bias + bcol0 + bj * HALF + 4 * n) : (f32x4){0.f, 0.f, 0.f, 0.f};
#pragma unroll
        for (int ai = 0; ai < 2; ++ai)
#pragma unroll
            for (int m = 0; m < 4; ++m) { bf16_t* rowp = base + (size_t)(row0 + ai * HALF + m * 16) * ldc + col0;
#pragma unroll
                for (int bj = 0; bj < 2; ++bj) { f32x4 v0 = acc[ai][bj][m][0] + bv[bj][0], v1 = acc[ai][bj][m][1] + bv[bj][1];
                    if (ACT == 1) { f32x2 a = gelu_pk((f32x2){v0[0], v0[1]}), b = gelu_pk((f32x2){v0[2], v0[3]}), c = gelu_pk((f32x2){v1[0], v1[1]}), d = gelu_pk((f32x2){v1[2], v1[3]});
                        v0 = (f32x4){a.x, a.y, b.x, b.y}; v1 = (f32x4){c.x, c.y, d.x, d.y}; }
                    v0 = v0 * sc; v1 = v1 * sc; u32x4 w; w.x = cvt_pk_bf16(v0[0], v0[1]); w.y = cvt_pk_bf16(v0[2], v0[3]); w.z = cvt_pk_bf16(v1[0], v1[1]); w.w = cvt_pk_bf16(v1[2], v1[3]);
                    *(u32x4*)(rowp + bj * HALF) = w; } }
    }
};
template <class Epi, class Sched, bool ALIGN_EPI = false, bool SP2 = false, bool TWO = false>
__device__ __forceinline__ void gemm_phase(PG8_LAS unsigned char* lds, const Gemm g, const Sched& S, const Epi& E, const int wave_s) {
    const int lane = fresh_lane(), wid = wave_s, tid = wid * 64 + lane, wr = wid >> 2, wc = wid & 3, fr = lane & 15, fq = lane >> 4;
    const int K = g.K, nt = K / BK, LD = TWO ? K / 2 : K, nt1 = TWO ? nt / 2 : nt; (void)nt1;
    unsigned voffA[2], voffB[2];
#pragma unroll
    for (int i = 0; i < 2; ++i) { int R, C; stage_rc(tid * 16 + i * 8192, R, C); const int Rb = Epi::PERM ? ((R & ~31) + perm32(R & 31)) : R;
        voffA[i] = (unsigned)(R * LD + C) * 2u; voffB[i] = (unsigned)(Rb * LD + C) * 2u; }
    const size_t kstep = (size_t)(BK * 2);
    const size_t hstep = (size_t)HALF * LD * 2;
    const size_t tstep = 2 * hstep;
    const unsigned ldsw = (unsigned)wid * 1024u;
    const int aoff = lds_byte(wr * 64 + fr, fq * 8), boff = lds_byte(wc * 32 + fr, fq * 8);
#define PG8_SA(b, h) (((b) * 2 + (h)) * HTB)
#define PG8_SB(b, h) ((4 + (b) * 2 + (h)) * HTB)
#define PG8_STAGE(bufoff, gbase, voff) do { _Pragma("unroll") for (int _i = 0; _i < 2; ++_i) \
        __builtin_amdgcn_global_load_lds((const unsigned*)((const char*)(gbase) + (voff)[_i]), (PG8_LAS unsigned*)(lds + (bufoff) + ldsw + _i * 8192), 16, 0, 0); } while (0)
#define PG8_LDA(dst, b, h) do { _Pragma("unroll") for (int m = 0; m < 4; ++m) _Pragma("unroll") for (int k = 0; k < 2; ++k) dst[m][k] = *(const PG8_LAS bf16x8*)(lds + PG8_SA(b, h) + aoff + m * 2048 + k * 1024); } while (0)
#define PG8_LDB(dst, b, h) do { _Pragma("unroll") for (int n = 0; n < 2; ++n) _Pragma("unroll") for (int k = 0; k < 2; ++k) dst[n][k] = *(const PG8_LAS bf16x8*)(lds + PG8_SB(b, h) + boff + n * 2048 + k * 1024); } while (0)
#define PG8_MMA(ai, bj, At, Bt) do { __builtin_amdgcn_s_setprio(1); _Pragma("unroll") for (int m = 0; m < 4; ++m) _Pragma("unroll") for (int n = 0; n < 2; ++n) _Pragma("unroll") for (int k = 0; k < 2; ++k) \
        acc[ai][bj][m][n] = __builtin_amdgcn_mfma_f32_16x16x32_bf16(Bt[n][k], At[m][k], acc[ai][bj][m][n], 0, 0, 0); __builtin_amdgcn_s_setprio(0); } while (0)
#define PG8_WAIT_V(n) asm volatile("s_waitcnt vmcnt(" #n ")" ::: "memory")
#define PG8_WAIT_L(n) asm volatile("s_waitcnt lgkmcnt(" #n ")" ::: "memory")
#define PG8_BAR __builtin_amdgcn_s_barrier()
#define PG8_SCHED __builtin_amdgcn_sched_barrier(0)
    Unit cur, nxt; int ui = 0;
    if (!S.next(0, cur)) return;
    f32x4 acc[2][2][4][2];
#pragma unroll
    for (int a = 0; a < 2; ++a)
#pragma unroll
        for (int b = 0; b < 2; ++b)
#pragma unroll
            for (int m = 0; m < 4; ++m)
#pragma unroll
                for (int n = 0; n < 2; ++n) acc[a][b][m][n] = (f32x4){0.f, 0.f, 0.f, 0.f};
    bf16x8 At[4][2], B0[2][2], B1[2][2];
    const char* cA = (const char*)g.A + (size_t)cur.pm * tstep; const char* cB = (const char*)g.Bt + (size_t)cur.pn * tstep;
    const char* cA2 = TWO ? (const char*)g.A2 + (size_t)cur.pm * tstep - (size_t)nt1 * kstep : cA; const char* cB2 = TWO ? (const char*)g.Bt2 + (size_t)cur.pn * tstep - (size_t)nt1 * kstep : cB;
    S.a_ready(cur);
    if constexpr (SP2) {
        PG8_STAGE(PG8_SB(0, 0), cB, voffB); PG8_STAGE(PG8_SB(0, 1), cB + hstep, voffB); PG8_STAGE(PG8_SA(0, 0), cA, voffA); PG8_STAGE(PG8_SA(0, 1), cA + hstep, voffA);
        if (wr == 1) PG8_BAR;
        PG8_WAIT_V(2); PG8_BAR;
        PG8_STAGE(PG8_SB(1, 0), cB + kstep, voffB); PG8_STAGE(PG8_SA(1, 0), cA + kstep, voffA); PG8_STAGE(PG8_SB(1, 1), cB + hstep + kstep, voffB);
        PG8_WAIT_V(6); PG8_BAR;
    } else {
        PG8_STAGE(PG8_SB(0, 0), cB, voffB); PG8_STAGE(PG8_SA(0, 0), cA, voffA); PG8_STAGE(PG8_SB(0, 1), cB + hstep, voffB); PG8_STAGE(PG8_SA(0, 1), cA + hstep, voffA);
        if (wr == 1) PG8_BAR;
        PG8_WAIT_V(4); PG8_BAR;
        PG8_STAGE(PG8_SB(1, 0), cB + kstep, voffB); PG8_STAGE(PG8_SA(1, 0), cA + kstep, voffA); PG8_STAGE(PG8_SB(1, 1), cB + hstep + kstep, voffB);
        PG8_WAIT_V(6); PG8_BAR;
    }
    for (;;) {
        const bool has_next = S.next(ui + 1, nxt);
        const char* nA = has_next ? (const char*)g.A + (size_t)nxt.pm * tstep : cA; const char* nB = has_next ? (const char*)g.Bt + (size_t)nxt.pn * tstep : cB;
        for (int t = 0; t < nt; t += 2) {
            const bool last = (t == nt - 2);
            const char* a1 = ((TWO && t >= nt1) ? cA2 : cA) + (size_t)(t + 1) * kstep;
            const char* a2 = last ? nA : ((TWO && t + 2 >= nt1) ? cA2 : cA) + (size_t)(t + 2) * kstep; const char* b2 = last ? nB : ((TWO && t + 2 >= nt1) ? cB2 : cB) + (size_t)(t + 2) * kstep;
            const char* a3 = a2 + kstep; const char* b3 = b2 + kstep;
            if (last && has_next) S.a_ready(nxt);
            if constexpr (SP2) {
            PG8_LDB(B0, 0, 0); PG8_LDB(B1, 0, 1); PG8_SCHED; PG8_LDA(At, 0, 0); PG8_STAGE(PG8_SA(1, 1), a1 + hstep, voffA);
            PG8_WAIT_V(8); PG8_WAIT_L(0); PG8_BAR; PG8_MMA(0, 0, At, B0); PG8_MMA(0, 1, At, B1); PG8_BAR; PG8_SCHED;
            PG8_LDA(At, 0, 1); PG8_STAGE(PG8_SB(0, 0), b2, voffB); PG8_STAGE(PG8_SB(0, 1), b2 + hstep, voffB); PG8_STAGE(PG8_SA(0, 0), a2, voffA);
            PG8_WAIT_V(8); PG8_WAIT_L(0); PG8_BAR; PG8_MMA(1, 0, At, B0); PG8_MMA(1, 1, At, B1); PG8_BAR; PG8_SCHED;
            PG8_LDB(B0, 1, 0); PG8_LDB(B1, 1, 1); PG8_SCHED; PG8_LDA(At, 1, 0); PG8_STAGE(PG8_SA(0, 1), a2 + hstep, voffA);
            PG8_WAIT_V(8); PG8_WAIT_L(0); PG8_BAR; PG8_MMA(0, 0, At, B0); PG8_MMA(0, 1, At, B1); PG8_BAR; PG8_SCHED;
            PG8_LDA(At, 1, 1); PG8_STAGE(PG8_SB(1, 0), b3, voffB); PG8_STAGE(PG8_SB(1, 1), b3 + hstep, voffB); PG8_STAGE(PG8_SA(1, 0), a3, voffA);
            PG8_WAIT_V(8); PG8_WAIT_L(0); PG8_BAR; PG8_MMA(1, 0, At, B0); PG8_MMA(1, 1, At, B1); PG8_BAR; PG8_SCHED;
            } else {
            PG8_LDB(B0, 0, 0); PG8_SCHED; PG8_LDA(At, 0, 0); PG8_STAGE(PG8_SA(1, 1), a1 + hstep, voffA);
            PG8_WAIT_L(8); PG8_BAR; PG8_WAIT_L(0); PG8_MMA(0, 0, At, B0); PG8_BAR; PG8_SCHED;
            PG8_LDB(B1, 0, 1); PG8_STAGE(PG8_SB(0, 0), b2, voffB);
            PG8_BAR; PG8_WAIT_L(0); PG8_MMA(0, 1, At, B1); PG8_BAR;
            PG8_LDA(At, 0, 1); PG8_STAGE(PG8_SA(0, 0), a2, voffA);
            PG8_BAR; PG8_WAIT_L(0); PG8_MMA(1, 0, At, B0); PG8_BAR; PG8_SCHED;
            PG8_STAGE(PG8_SB(0, 1), b2 + hstep, voffB);
            PG8_WAIT_V(6); PG8_BAR; PG8_MMA(1, 1, At, B1); PG8_BAR;
            PG8_LDB(B0, 1, 0); PG8_SCHED; PG8_LDA(At, 1, 0); PG8_STAGE(PG8_SA(0, 1), a2 + hstep, voffA);
            PG8_WAIT_L(8); PG8_BAR; PG8_WAIT_L(0); PG8_MMA(0, 0, At, B0); PG8_BAR; PG8_SCHED;
            PG8_LDB(B1, 1, 1); PG8_STAGE(PG8_SB(1, 0), b3, voffB);
            PG8_BAR; PG8_WAIT_L(0); PG8_MMA(0, 1, At, B1); PG8_BAR;
            PG8_LDA(At, 1, 1); PG8_STAGE(PG8_SA(1, 0), a3, voffA);
            PG8_BAR; PG8_WAIT_L(0); PG8_MMA(1, 0, At, B0); PG8_BAR; PG8_SCHED;
            PG8_STAGE(PG8_SB(1, 1), b3 + hstep, voffB);
            PG8_WAIT_V(6); PG8_BAR; PG8_MMA(1, 1, At, B1); PG8_BAR;
            }
            if constexpr (TWO) { if (t == nt1 - 2) E.mid(acc, cur, wr, wc, fr, fq); }
        }
        if constexpr (ALIGN_EPI) { if (wr == 0) PG8_BAR; }
        if constexpr (!Epi::AFTER_DRAIN) { E(acc, cur, wr, wc, fr, fq); S.done(cur); }
        if (!has_next) break;
#pragma unroll
        for (int a = 0; a < 2; ++a)
#pragma unroll
            for (int b = 0; b < 2; ++b)
#pragma unroll
                for (int m = 0; m < 4; ++m)
#pragma unroll
                    for (int n = 0; n < 2; ++n) acc[a][b][m][n] = (f32x4){0.f, 0.f, 0.f, 0.f};
        cur = nxt; cA = nA; cB = nB; ++ui;
        if constexpr (TWO) { cA2 = (const char*)g.A2 + (size_t)cur.pm * tstep - (size_t)nt1 * kstep; cB2 = (const char*)g.Bt2 + (size_t)cur.pn * tstep - (size_t)nt1 * kstep; }
        if constexpr (ALIGN_EPI) { if (wr == 1) PG8_BAR; }
    }
    PG8_WAIT_V(0);
    if constexpr (!ALIGN_EPI) { if (wr == 0) PG8_BAR; }
    PG8_BAR;
    if constexpr (Epi::AFTER_DRAIN) { E.fused(acc, cur, wr, wc, fr, fq, lds, wid, lane); S.done(cur); }
#undef PG8_SA
#undef PG8_SB
#undef PG8_STAGE
#undef PG8_LDA
#undef PG8_LDB
#undef PG8_MMA
#undef PG8_WAIT_V
#undef PG8_WAIT_L
#undef PG8_BAR
#undef PG8_SCHED
}
}

namespace pg8 {
__device__ __forceinline__ float e_lo(unsigned w) { return __uint_as_float(w << 16); }
__device__ __forceinline__ float e_hi(unsigned w) { return __uint_as_float(w & 0xffff0000u); }
__device__ __forceinline__ float e_sig(float x) { return __builtin_amdgcn_rcpf(1.f + __expf(-x)); }
struct EpiGateA {
    static constexpr bool PERM = true, AFTER_DRAIN = false;
    const bf16_t* gate; bf16_t* T;
    __device__ __forceinline__ void operator()(const f32x4 (&acc)[2][2][4][2], const Unit& u, int wr, int wc, int fr, int fq) const {
        const int row0 = u.pm * BM + wr * 64 + fr, col0 = u.pn * BM + wc * 32 + 8 * fq;
#pragma unroll
        for (int ai = 0; ai < 2; ++ai)
#pragma unroll
            for (int m = 0; m < 4; ++m) { const size_t ro = (size_t)(row0 + ai * HALF + m * 16) * 1024 + col0;
#pragma unroll
                for (int bj = 0; bj < 2; ++bj) { const size_t off = ro + bj * HALF; const u32x4 g = *(const u32x4*)(gate + off);
                    const f32x4 v0 = acc[ai][bj][m][0], v1 = acc[ai][bj][m][1]; u32x4 w;
                    w.x = cvt_pk_bf16(v0[0] * e_sig(e_lo(g.x)), v0[1] * e_sig(e_hi(g.x))); w.y = cvt_pk_bf16(v0[2] * e_sig(e_lo(g.y)), v0[3] * e_sig(e_hi(g.y)));
                    w.z = cvt_pk_bf16(v1[0] * e_sig(e_lo(g.z)), v1[1] * e_sig(e_hi(g.z))); w.w = cvt_pk_bf16(v1[2] * e_sig(e_lo(g.w)), v1[3] * e_sig(e_hi(g.w)));
                    *(u32x4*)(T + off) = w; } }
    }
};
struct EpiGateB {
    static constexpr bool PERM = true, AFTER_DRAIN = false;
    const bf16_t* gate; bf16_t* T;
    __device__ __forceinline__ void operator()(const f32x4 (&acc)[2][2][4][2], const Unit& u, int wr, int wc, int fr, int fq) const {
        const int row0 = u.pm * BM + wr * 64 + fr, col0 = u.pn * BM + wc * 32 + 8 * fq;
#pragma unroll
        for (int ai = 0; ai < 2; ++ai)
#pragma unroll
            for (int m = 0; m < 4; ++m) { const size_t ro = (size_t)(row0 + ai * HALF + m * 16) * 1024 + col0;
#pragma unroll
                for (int bj = 0; bj < 2; ++bj) { const size_t off = ro + bj * HALF; const u32x4 g = *(const u32x4*)(gate + off); const u32x4 t = *(const u32x4*)(T + off);
                    const f32x4 v0 = acc[ai][bj][m][0], v1 = acc[ai][bj][m][1]; u32x4 w;
                    w.x = cvt_pk_bf16(e_lo(t.x) + v0[0] * e_sig(e_lo(g.x)), e_hi(t.x) + v0[1] * e_sig(e_hi(g.x))); w.y = cvt_pk_bf16(e_lo(t.y) + v0[2] * e_sig(e_lo(g.y)), e_hi(t.y) + v0[3] * e_sig(e_hi(g.y)));
                    w.z = cvt_pk_bf16(e_lo(t.z) + v1[0] * e_sig(e_lo(g.z)), e_hi(t.z) + v1[1] * e_sig(e_hi(g.z))); w.w = cvt_pk_bf16(e_lo(t.w) + v1[2] * e_sig(e_lo(g.w)), e_hi(t.w) + v1[3] * e_sig(e_hi(g.w)));
                    *(u32x4*)(T + off) = w; } }
    }
};
struct EpiRes1 {
    static constexpr bool PERM = true, AFTER_DRAIN = false;
    const float* x; bf16_t* xb; float* ssq;
    __device__ __forceinline__ void operator()(const f32x4 (&acc)[2][2][4][2], const Unit& u, int wr, int wc, int fr, int fq) const {
        const int row0 = u.pm * BM + wr * 64 + fr, col0 = u.pn * BM + wc * 32 + 8 * fq;
        size_t base = (size_t)row0 * 1024 + col0; asm volatile("" : "+v"(base));
        u32x4 R[2][4][2]; float S[2][4];
#pragma unroll
        for (int ai = 0; ai < 2; ++ai) {
            f32x4 L[4][2][2];
#pragma unroll
            for (int m = 0; m < 4; ++m)
#pragma unroll
                for (int bj = 0; bj < 2; ++bj) { const size_t off = base + (size_t)(ai * HALF + m * 16) * 1024 + bj * HALF; L[m][bj][0] = *(const f32x4*)(x + off); L[m][bj][1] = *(const f32x4*)(x + off + 4); }
            asm volatile("" ::: "memory");
#pragma unroll
            for (int m = 0; m < 4; ++m) { float s = 0.f;
#pragma unroll
                for (int bj = 0; bj < 2; ++bj) { const f32x4 a0 = L[m][bj][0] + acc[ai][bj][m][0], a1 = L[m][bj][1] + acc[ai][bj][m][1];
                    s += (a0[0] * a0[0] + a0[1] * a0[1]) + (a0[2] * a0[2] + a0[3] * a0[3]) + (a1[0] * a1[0] + a1[1] * a1[1]) + (a1[2] * a1[2] + a1[3] * a1[3]);
                    u32x4 w; w.x = cvt_pk_bf16(a0[0], a0[1]); w.y = cvt_pk_bf16(a0[2], a0[3]); w.z = cvt_pk_bf16(a1[0], a1[1]); w.w = cvt_pk_bf16(a1[2], a1[3]); R[ai][m][bj] = w; }
                s += __shfl_xor(s, 16); s += __shfl_xor(s, 32); S[ai][m] = s; }
            asm volatile("" ::: "memory");
        }
#pragma unroll
        for (int ai = 0; ai < 2; ++ai)
#pragma unroll
            for (int m = 0; m < 4; ++m) { const int row = row0 + ai * HALF + m * 16; const size_t ro = base + (size_t)(ai * HALF + m * 16) * 1024;
                *(u32x4*)(xb + ro) = R[ai][m][0]; *(u32x4*)(xb + ro + HALF) = R[ai][m][1];
                if (fq == 0) unsafeAtomicAdd(ssq + row, S[ai][m]); }
    }
};
struct EpiUp {
    static constexpr bool PERM = true, AFTER_DRAIN = false;
    const float* ssq; bf16_t* H;
    __device__ __forceinline__ void operator()(const f32x4 (&acc)[2][2][4][2], const Unit& u, int wr, int wc, int fr, int fq) const {
        const int row0 = u.pm * BM + wr * 64 + fr, col0 = u.pn * BM + wc * 32 + 8 * fq;
        float r2[2][4];
#pragma unroll
        for (int ai = 0; ai < 2; ++ai)
#pragma unroll
            for (int m = 0; m < 4; ++m) r2[ai][m] = ssq[row0 + ai * HALF + m * 16];
        asm volatile("" ::: "memory");
#pragma unroll
        for (int ai = 0; ai < 2; ++ai)
#pragma unroll
            for (int m = 0; m < 4; ++m) { const int row = row0 + ai * HALF + m * 16; const float rr = 1.0f / (r2[ai][m] * (1.0f / 1024.0f) + 1e-6f);
#pragma unroll
                for (int bj = 0; bj < 2; ++bj) { const size_t off = (size_t)row * 4096 + col0 + bj * HALF;
                    f32x4 v0 = acc[ai][bj][m][0], v1 = acc[ai][bj][m][1];
#pragma unroll
                    for (int i = 0; i < 4; ++i) { const float a = fmaxf(v0[i], 0.f), b = fmaxf(v1[i], 0.f); v0[i] = a * a * rr; v1[i] = b * b * rr; }
                    u32x4 w; w.x = cvt_pk_bf16(v0[0], v0[1]); w.y = cvt_pk_bf16(v0[2], v0[3]); w.z = cvt_pk_bf16(v1[0], v1[1]); w.w = cvt_pk_bf16(v1[2], v1[3]);
                    *(u32x4*)(H + off) = w; } }
    }
};
struct EpiDown {
    static constexpr bool PERM = true, AFTER_DRAIN = false;
    float* x1;
    __device__ __forceinline__ void operator()(const f32x4 (&acc)[2][2][4][2], const Unit& u, int wr, int wc, int fr, int fq) const {
        const int row0 = u.pm * BM + wr * 64 + fr, col0 = u.pn * BM + wc * 32 + 8 * fq;
#pragma unroll
        for (int ai = 0; ai < 2; ++ai)
#pragma unroll
            for (int m = 0; m < 4; ++m) { const size_t ro = (size_t)(row0 + ai * HALF + m * 16) * 1024 + col0;
#pragma unroll
                for (int bj = 0; bj < 2; ++bj) { const size_t off = ro + bj * HALF;
                    const f32x4 a0 = *(const f32x4*)(x1 + off) + acc[ai][bj][m][0], a1 = *(const f32x4*)(x1 + off + 4) + acc[ai][bj][m][1];
                    *(f32x4*)(x1 + off) = a0; *(f32x4*)(x1 + off + 4) = a1; } }
    }
};

struct EpiDownNorm {
    static constexpr bool PERM = true, AFTER_DRAIN = false;
    const bf16_t* x1; float* out; const float* gfin; float* ssq; unsigned* cnt;
    __device__ __forceinline__ void operator()(const f32x4 (&acc_)[2][2][4][2], const Unit& u, int wr, int wc, int fr, int fq) const {
        f32x4 (&acc)[2][2][4][2] = const_cast<f32x4 (&)[2][2][4][2]>(acc_);
        const int row0 = u.pm * BM + wr * 64 + fr, col0 = u.pn * BM + wc * 32 + 8 * fq;
        size_t base = (size_t)row0 * 1024 + col0; asm volatile("" : "+v"(base));
        float S[2][4];
        {
            u32x4 L[2][4][2];
#pragma unroll
            for (int ai = 0; ai < 2; ++ai)
#pragma unroll
                for (int m = 0; m < 4; ++m)
#pragma unroll
                    for (int bj = 0; bj < 2; ++bj) L[ai][m][bj] = *(const u32x4*)(x1 + base + (size_t)(ai * HALF + m * 16) * 1024 + bj * HALF);
            asm volatile("" ::: "memory");
#pragma unroll
            for (int ai = 0; ai < 2; ++ai)
#pragma unroll
                for (int m = 0; m < 4; ++m) { float s = 0.f;
#pragma unroll
                    for (int bj = 0; bj < 2; ++bj) { const u32x4 xr = L[ai][m][bj];
                        const f32x4 a0 = (f32x4){e_lo(xr.x), e_hi(xr.x), e_lo(xr.y), e_hi(xr.y)} + acc[ai][bj][m][0], a1 = (f32x4){e_lo(xr.z), e_hi(xr.z), e_lo(xr.w), e_hi(xr.w)} + acc[ai][bj][m][1];
                        acc[ai][bj][m][0] = a0; acc[ai][bj][m][1] = a1;
                        s += (a0[0] * a0[0] + a0[1] * a0[1]) + (a0[2] * a0[2] + a0[3] * a0[3]) + (a1[0] * a1[0] + a1[1] * a1[1]) + (a1[2] * a1[2] + a1[3] * a1[3]); }
                    s += __shfl_xor(s, 16); s += __shfl_xor(s, 32); S[ai][m] = s; }
        }
        asm volatile("" ::: "memory");
        if (fq == 0) {
#pragma unroll
            for (int ai = 0; ai < 2; ++ai)
#pragma unroll
                for (int m = 0; m < 4; ++m) unsafeAtomicAdd(ssq + row0 + ai * HALF + m * 16, S[ai][m]); }
        asm volatile("s_waitcnt vmcnt(0)" ::: "memory");
        unsigned* pc = cnt + 64 * u.pm;
        if (fr == 0 && fq == 0) __hip_atomic_fetch_add(pc, 1u, __ATOMIC_RELAXED, __HIP_MEMORY_SCOPE_AGENT);
        f32x4 gv[2][2];
#pragma unroll
        for (int bj = 0; bj < 2; ++bj) { gv[bj][0] = *(const f32x4*)(gfin + col0 + bj * HALF); gv[bj][1] = *(const f32x4*)(gfin + col0 + bj * HALF + 4); }
        { unsigned sp = 0; while ((unsigned)__builtin_amdgcn_readfirstlane(__hip_atomic_load(pc, __ATOMIC_RELAXED, __HIP_MEMORY_SCOPE_AGENT)) < 32u) { __builtin_amdgcn_s_sleep(2); if (++sp > (1u << 22)) break; } }
        float tot[2][4];
#pragma unroll
        for (int ai = 0; ai < 2; ++ai)
#pragma unroll
            for (int m = 0; m < 4; ++m) tot[ai][m] = __hip_atomic_load(ssq + row0 + ai * HALF + m * 16, __ATOMIC_RELAXED, __HIP_MEMORY_SCOPE_AGENT);
        asm volatile("" ::: "memory");
#pragma unroll
        for (int ai = 0; ai < 2; ++ai)
#pragma unroll
            for (int m = 0; m < 4; ++m) { const size_t ro = base + (size_t)(ai * HALF + m * 16) * 1024;
                const float rstd = 1.0f / sqrtf(tot[ai][m] * (1.0f / 1024.0f) + 1e-6f);
#pragma unroll
                for (int bj = 0; bj < 2; ++bj) { const size_t off = ro + bj * HALF;
                    *(f32x4*)(out + off) = acc[ai][bj][m][0] * rstd * gv[bj][0]; *(f32x4*)(out + off + 4) = acc[ai][bj][m][1] * rstd * gv[bj][1]; } }
    }
};

struct EpiMix {
    static constexpr bool PERM = true, AFTER_DRAIN = false;
    const bf16_t* ga; const bf16_t* gb; bf16_t* T;
    __device__ __forceinline__ void mid(f32x4 (&acc)[2][2][4][2], const Unit& u, int wr, int wc, int fr, int fq) const {
        const int row0 = u.pm * BM + wr * 64 + fr, col0 = u.pn * BM + wc * 32 + 8 * fq;
        size_t base = (size_t)row0 * 1024 + col0; asm volatile("" : "+v"(base));
#pragma unroll
        for (int ai = 0; ai < 2; ++ai) {
            u32x4 A[4][2], B[4][2];
#pragma unroll
            for (int m = 0; m < 4; ++m)
#pragma unroll
                for (int bj = 0; bj < 2; ++bj) { const size_t off = base + (size_t)(ai * HALF + m * 16) * 1024 + bj * HALF; A[m][bj] = *(const u32x4*)(ga + off); B[m][bj] = *(const u32x4*)(gb + off); }
            asm volatile("" ::: "memory");
#pragma unroll
            for (int m = 0; m < 4; ++m)
#pragma unroll
                for (int bj = 0; bj < 2; ++bj) { const u32x4 a = A[m][bj], b = B[m][bj];
#pragma unroll
                    for (int w = 0; w < 4; ++w) { const float r0 = (1.f + __expf(-fmaxf(e_lo(b[w]), -80.f))) * __builtin_amdgcn_rcpf(1.f + __expf(-e_lo(a[w]))), r1 = (1.f + __expf(-fmaxf(e_hi(b[w]), -80.f))) * __builtin_amdgcn_rcpf(1.f + __expf(-e_hi(a[w])));
                        acc[ai][bj][m][w >> 1][2 * (w & 1)] *= r0; acc[ai][bj][m][w >> 1][2 * (w & 1) + 1] *= r1; } }
            asm volatile("" ::: "memory");
        }
    }
    __device__ __forceinline__ void operator()(const f32x4 (&acc)[2][2][4][2], const Unit& u, int wr, int wc, int fr, int fq) const {
        const int row0 = u.pm * BM + wr * 64 + fr, col0 = u.pn * BM + wc * 32 + 8 * fq;
        size_t base = (size_t)row0 * 1024 + col0; asm volatile("" : "+v"(base));
        u32x4 Gt[2][4][2];
#pragma unroll
        for (int ai = 0; ai < 2; ++ai)
#pragma unroll
            for (int m = 0; m < 4; ++m)
#pragma unroll
                for (int bj = 0; bj < 2; ++bj) Gt[ai][m][bj] = *(const u32x4*)(gb + base + (size_t)(ai * HALF + m * 16) * 1024 + bj * HALF);
        asm volatile("" ::: "memory");
#pragma unroll
        for (int ai = 0; ai < 2; ++ai)
#pragma unroll
            for (int m = 0; m < 4; ++m)
#pragma unroll
                for (int bj = 0; bj < 2; ++bj) { const u32x4 g = Gt[ai][m][bj]; const f32x4 v0 = acc[ai][bj][m][0], v1 = acc[ai][bj][m][1]; u32x4 w;
                    w.x = cvt_pk_bf16(v0[0] * e_sig(fmaxf(e_lo(g.x), -80.f)), v0[1] * e_sig(fmaxf(e_hi(g.x), -80.f))); w.y = cvt_pk_bf16(v0[2] * e_sig(fmaxf(e_lo(g.y), -80.f)), v0[3] * e_sig(fmaxf(e_hi(g.y), -80.f)));
                    w.z = cvt_pk_bf16(v1[0] * e_sig(fmaxf(e_lo(g.z), -80.f)), v1[1] * e_sig(fmaxf(e_hi(g.z), -80.f))); w.w = cvt_pk_bf16(v1[2] * e_sig(fmaxf(e_lo(g.w), -80.f)), v1[3] * e_sig(fmaxf(e_hi(g.w), -80.f)));
                    Gt[ai][m][bj] = w; }
        asm volatile("" ::: "memory");
#pragma unroll
        for (int ai = 0; ai < 2; ++ai)
#pragma unroll
            for (int m = 0; m < 4; ++m)
#pragma unroll
                for (int bj = 0; bj < 2; ++bj) *(u32x4*)(T + base + (size_t)(ai * HALF + m * 16) * 1024 + bj * HALF) = Gt[ai][m][bj];
    }
};

struct EpiNull { static constexpr bool PERM = true, AFTER_DRAIN = false;
    __device__ __forceinline__ void operator()(const f32x4 (&acc)[2][2][4][2], const Unit& u, int wr, int wc, int fr, int fq) const { float s = 0.f;
#pragma unroll
        for (int a = 0; a < 2; ++a)
#pragma unroll
            for (int b = 0; b < 2; ++b)
#pragma unroll
                for (int m = 0; m < 4; ++m)
#pragma unroll
                    for (int n = 0; n < 2; ++n) s += (acc[a][b][m][n][0] + acc[a][b][m][n][1]) + (acc[a][b][m][n][2] + acc[a][b][m][n][3]);
        if (s == 123456.789f) asm volatile("s_nop 0"); } };

struct EpiProj {
    static constexpr bool PERM = true, AFTER_DRAIN = false;
    bf16_t* O; size_t split_stride; unsigned* KP;
    __device__ __forceinline__ void operator()(const f32x4 (&acc)[2][2][4][2], const Unit& u, int wr, int wc, int fr, int fq) const {
        const int plane = u.pn >> 2; bf16_t* base = O + (size_t)plane * split_stride;
        const int row0 = u.pm * BM + wr * 64 + fr, col0 = (u.pn & 3) * BM + wc * 32 + 8 * fq;
#pragma unroll
        for (int ai = 0; ai < 2; ++ai)
#pragma unroll
            for (int m = 0; m < 4; ++m) { bf16_t* rowp = base + (size_t)(row0 + ai * HALF + m * 16) * 1024 + col0;
#pragma unroll
                for (int bj = 0; bj < 2; ++bj) { const f32x4 v0 = acc[ai][bj][m][0], v1 = acc[ai][bj][m][1];
                    u32x4 w; w.x = cvt_pk_bf16(v0[0], v0[1]); w.y = cvt_pk_bf16(v0[2], v0[3]); w.z = cvt_pk_bf16(v1[0], v1[1]); w.w = cvt_pk_bf16(v1[2], v1[3]);
                    *(u32x4*)(rowp + bj * HALF) = w; } }
        if (plane == 3) {
#pragma unroll
            for (int bj = 0; bj < 2; ++bj) { float mx = 0.f;
#pragma unroll
                for (int ai = 0; ai < 2; ++ai)
#pragma unroll
                    for (int m = 0; m < 4; ++m) { const f32x4 v0 = acc[ai][bj][m][0], v1 = acc[ai][bj][m][1];
                        float ss = (v0[0] * v0[0] + v0[1] * v0[1]) + (v0[2] * v0[2] + v0[3] * v0[3]) + (v1[0] * v1[0] + v1[1] * v1[1]) + (v1[2] * v1[2] + v1[3] * v1[3]);
                        ss += __shfl_xor(ss, 16); ss += __shfl_xor(ss, 32); mx = fmaxf(mx, ss); }
                mx = fmaxf(mx, __shfl_xor(mx, 1)); mx = fmaxf(mx, __shfl_xor(mx, 2)); mx = fmaxf(mx, __shfl_xor(mx, 4)); mx = fmaxf(mx, __shfl_xor(mx, 8));
                if (fr == 0 && fq == 0) atomicMax(KP + (((u.pm >> 5) * 8 + 2 * (u.pn & 3) + bj) * 4 + wc), __float_as_uint(mx)); }
        }
    }
};
}

namespace att {
constexpr int D = 128, PITCH = 1024;
constexpr float THR = 8.f;
constexpr bool WSKIP = false;
constexpr float SCALE = 0.08838834764831845f;
constexpr int NW = 8, QBLK = 32, KVBLK = 64, QB = NW * QBLK;
constexpr int SHM_V = KVBLK * D * 2, SHM_K = KVBLK * D * 2;
constexpr int ATT_LDS_BYTES = 2 * SHM_V + 2 * SHM_K + NW * 64 * 4 + 2 * 64 * 4;
using bf16 = __hip_bfloat16;
typedef short bf16x8 __attribute__((ext_vector_type(8)));
typedef short s16x4 __attribute__((ext_vector_type(4)));
typedef float f32x16 __attribute__((ext_vector_type(16)));
typedef float f32x4 __attribute__((ext_vector_type(4)));
typedef unsigned u32x4 __attribute__((ext_vector_type(4)));
template <class A, class Bt> struct same_t { static constexpr bool v = false; };
template <class A> struct same_t<A, A> { static constexpr bool v = true; };

#define KSWZ(row, colB) ((row) * 256 + ((colB) ^ (((row) & 7) << 4)))
#define SBAR() __builtin_amdgcn_sched_barrier(0)
__device__ __forceinline__ int v_st(int k, int c) { const int kk = (k & ~0xC) | ((k & 4) << 1) | ((k & 8) >> 1); return ((kk >> 3) * 4 + (c >> 5)) * 512 + ((kk & 7) * 32 + (c & 31)) * 2; }
__device__ __forceinline__ int v_rd_base(int lane) { return ((lane & 3) << 3) | (((lane >> 2) & 3) << 6) | (((lane >> 4) & 1) << 5) | (((lane >> 5) & 1) << 8); }
constexpr int v_rd_off(int d0, int ks, int half) { return d0 * 512 + ks * 4096 + half * 2048; }
__device__ __forceinline__ int crow(int r, int hi) { return (r & 3) + 8 * (r >> 2) + 4 * hi; }
__device__ __forceinline__ unsigned cvtpk(float lo, float hi) {
    unsigned r; asm volatile("v_cvt_pk_bf16_f32 %0, %1, %2" : "=v"(r) : "v"(lo), "v"(hi)); return r;
}
__device__ __forceinline__ bf16x8 pack8(f32x4 a, f32x4 b) {
    u32x4 w = {cvtpk(a[0], a[1]), cvtpk(a[2], a[3]), cvtpk(b[0], b[1]), cvtpk(b[2], b[3])};
    return *reinterpret_cast<bf16x8*>(&w);
}
template <class T> __device__ __forceinline__ bf16x8 load8(const T* p) {
    if constexpr (same_t<T, float>::v) { return pack8(*(const f32x4*)p, *(const f32x4*)(p + 4)); }
    else { return *reinterpret_cast<const bf16x8*>(p); }
}
__device__ __forceinline__ void mask_tile(f32x16& p0, f32x16& p1, int dq, unsigned W) {
    const float NEG = -__builtin_inff();
#pragma unroll
    for (int r = 0; r < 16; ++r) {
        const int c = (r & 3) + 8 * (r >> 2);
        if ((unsigned)(dq - c) >= W) p0[r] = NEG;
        if ((unsigned)(dq - c - 32) >= W) p1[r] = NEG;
    }
}
__device__ __forceinline__ void partialSM(f32x16& p0, f32x16& p1, float& m_reg, float& mn, float& alpha) {
    float pmax = p0[0]; for (int r = 1; r < 16; ++r) pmax = fmaxf(pmax, p0[r]); for (int r = 0; r < 16; ++r) pmax = fmaxf(pmax, p1[r]);
    { auto rr = __builtin_amdgcn_permlane32_swap(__float_as_uint(pmax), __float_as_uint(pmax), false, false);
      pmax = fmaxf(__uint_as_float(rr[0]), __uint_as_float(rr[1])); }
    constexpr float C2 = 1.4426950408889634f * SCALE;
    if (__builtin_expect(__all((pmax - m_reg) * SCALE <= THR), 1)) { mn = m_reg; alpha = 1.f; }
    else { mn = fmaxf(m_reg, pmax); alpha = __builtin_amdgcn_exp2f((m_reg - mn) * C2); m_reg = mn; }
    const float mnL = -mn * C2;
    for (int r = 0; r < 16; ++r) p0[r] = fmaf(p0[r], C2, mnL); for (int r = 0; r < 16; ++r) p1[r] = fmaf(p1[r], C2, mnL);
    for (int r = 0; r < 16; ++r) p0[r] = __builtin_amdgcn_exp2f(p0[r]);
}
__device__ __forceinline__ void finishSM(f32x16& p0, f32x16& p1, float alpha, float& l_reg, bf16x8& pa0, bf16x8& pa1, bf16x8& pa2, bf16x8& pa3) {
    for (int r = 0; r < 16; ++r) p1[r] = __builtin_amdgcn_exp2f(p1[r]);
    float ps = 0; for (int r = 0; r < 16; ++r) ps += p0[r]; for (int r = 0; r < 16; ++r) ps += p1[r];
    { auto rr = __builtin_amdgcn_permlane32_swap(__float_as_uint(ps), __float_as_uint(ps), false, false);
      ps = __uint_as_float(rr[0]) + __uint_as_float(rr[1]); }
    l_reg = l_reg * alpha + ps;
#define PK4(P, B_, OUT) do { unsigned a0 = cvtpk(P[B_+0], P[B_+1]), a1 = cvtpk(P[B_+2], P[B_+3]);                          \
        unsigned b0 = cvtpk(P[B_+4], P[B_+5]), b1 = cvtpk(P[B_+6], P[B_+7]);                                             \
        auto r0 = __builtin_amdgcn_permlane32_swap(a0, b0, false, false); auto r1 = __builtin_amdgcn_permlane32_swap(a1, b1, false, false); \
        u32x4 w = {r0[0], r1[0], r0[1], r1[1]}; OUT = *reinterpret_cast<bf16x8*>(&w); } while (0)
    PK4(p0, 0, pa0); PK4(p0, 8, pa1); PK4(p1, 0, pa2); PK4(p1, 8, pa3);
#undef PK4
}
template <int KB, bool SK>
__device__ __forceinline__ void qkt(f32x16& p0, f32x16& p1, const char* K_lds, int r32, int hi, const bf16x8* qr, bool act) {
    if (SK && !act) { const float NEG = -__builtin_inff();
#pragma unroll
        for (int r = 0; r < 16; ++r) { p0[r] = NEG; p1[r] = NEG; } return; }
    { const char* bl = K_lds + 2 * SHM_K + NW * 64 * 4 + KB * 256 + hi * 16;
#pragma unroll
      for (int g = 0; g < 4; ++g) { const f32x4 t0 = *reinterpret_cast<const f32x4*>(bl + g * 32), t1 = *reinterpret_cast<const f32x4*>(bl + 128 + g * 32);
        p0[4 * g] = t0[0]; p0[4 * g + 1] = t0[1]; p0[4 * g + 2] = t0[2]; p0[4 * g + 3] = t0[3]; p1[4 * g] = t1[0]; p1[4 * g + 1] = t1[1]; p1[4 * g + 2] = t1[2]; p1[4 * g + 3] = t1[3]; } }
    const char* kb[4];
#pragma unroll
    for (int dd = 0; dd < 4; ++dd) kb[dd] = K_lds + KB * SHM_K + KSWZ(r32, (dd * 16 + hi * 8) * 2);
#pragma unroll
    for (int d0 = 0; d0 < 8; ++d0) { const char* a = kb[d0 & 3] + (d0 >> 2) * 128;
        bf16x8 b0 = *reinterpret_cast<const bf16x8*>(a);
        bf16x8 b1 = *reinterpret_cast<const bf16x8*>(a + 32 * 256);
        p0 = __builtin_amdgcn_mfma_f32_32x32x16_bf16(b0, qr[d0], p0, 0, 0, 0);
        p1 = __builtin_amdgcn_mfma_f32_32x32x16_bf16(b1, qr[d0], p1, 0, 0, 0); }
}
template <int VB, bool SK>
__device__ __forceinline__ void pv_tile(f32x16* o, int vb0, bf16x8 pa0, bf16x8 pa1, bf16x8 pa2, bf16x8 pa3, bool act) {
    if (SK && !act) return;
#define TRRD(dst, off) asm volatile("ds_read_b64_tr_b16 %0, %1 offset:%2" : "=&v"(dst) : "v"(vb0), "i"(off) : "memory")
#define PV_D0(d0) do { s16x4 l0, l1, l2, l3, h0, h1, h2, h3; constexpr int b_ = VB * SHM_V + v_rd_off(d0, 0, 0);     \
        TRRD(l0, b_); TRRD(h0, b_ + 2048); TRRD(l1, b_ + 4096); TRRD(h1, b_ + 6144); TRRD(l2, b_ + 8192); TRRD(h2, b_ + 10240); TRRD(l3, b_ + 12288); TRRD(h3, b_ + 14336); \
        asm volatile("s_waitcnt lgkmcnt(0)" ::: "memory"); SBAR();                 \
        o[d0] = __builtin_amdgcn_mfma_f32_32x32x16_bf16(pa0, (bf16x8){l0[0], l0[1], l0[2], l0[3], h0[0], h0[1], h0[2], h0[3]}, o[d0], 0, 0, 0);   \
        o[d0] = __builtin_amdgcn_mfma_f32_32x32x16_bf16(pa1, (bf16x8){l1[0], l1[1], l1[2], l1[3], h1[0], h1[1], h1[2], h1[3]}, o[d0], 0, 0, 0);   \
        o[d0] = __builtin_amdgcn_mfma_f32_32x32x16_bf16(pa2, (bf16x8){l2[0], l2[1], l2[2], l2[3], h2[0], h2[1], h2[2], h2[3]}, o[d0], 0, 0, 0);   \
        o[d0] = __builtin_amdgcn_mfma_f32_32x32x16_bf16(pa3, (bf16x8){l3[0], l3[1], l3[2], l3[3], h3[0], h3[1], h3[2], h3[3]}, o[d0], 0, 0, 0); } while (0)
    PV_D0(0); PV_D0(1); PV_D0(2); PV_D0(3);
#undef PV_D0
#undef TRRD
}

template <class TIn, class TOut> struct BlockRef { const TIn* Q; const TIn* K; const TIn* V; TOut* O; const float* G; int P0; int jlo; };
template <class TIn> struct Seam {
    bf16x8 qr[8];
    bf16x8 st_v0, st_v1, st_k0, st_k1; float st_b; f32x4 sf0, sf1, sf2, sf3;
    f32x4 tq[16];
};
__device__ __forceinline__ int swa_jlo(int P0, int W) { const int lowk = P0 - W + 1; return lowk > 0 ? lowk / KVBLK : 0; }
#define ROW(p, k0, rr) ((p) + (size_t)((k0) + (rr)) * PITCH + sc)
#define VMW() asm volatile("s_waitcnt vmcnt(0)" ::: "memory")
#define VMWN(n) asm volatile("s_waitcnt vmcnt(%0)" :: "i"(n) : "memory")
#define SLOAD_H(Kp, Vp, Gp, k0) do { S.st_b = (Gp)[(k0) + (tid & 63)]; S.st_v0 = load8<TIn>(ROW(Vp, k0, sr)); S.st_v1 = load8<TIn>(ROW(Vp, k0, 32 + sr));              \
                         S.st_k0 = load8<TIn>(ROW(Kp, k0, sr)); S.st_k1 = load8<TIn>(ROW(Kp, k0, 32 + sr)); } while (0)
#define SWRITE_HK(bf) do { if (tid < 64) ((float*)(K_lds + 2 * SHM_K + NW * 64 * 4))[(bf) * 64 + tid] = S.st_b; *(bf16x8*)(K_lds + (bf) * SHM_K + kws) = S.st_k0; *(bf16x8*)(K_lds + (bf) * SHM_K + kws + 32 * 256) = S.st_k1; } while (0)
#define SWRITE_HV(bf) do { *(bf16x8*)(V_lds + (bf) * SHM_V + vst0) = S.st_v0; *(bf16x8*)(V_lds + (bf) * SHM_V + vst1) = S.st_v1; } while (0)
#define SWRITE_H(bf) do { SWRITE_HV(bf); SWRITE_HK(bf); } while (0)
#define SLOAD_F(p, k0) do { S.sf0 = *(const f32x4*)ROW(p, k0, sr); S.sf1 = *(const f32x4*)(ROW(p, k0, sr) + 4);                \
                            S.sf2 = *(const f32x4*)ROW(p, k0, 32 + sr); S.sf3 = *(const f32x4*)(ROW(p, k0, 32 + sr) + 4); } while (0)
#define SWRITE_KF(bf) do { *(bf16x8*)(K_lds + (bf) * SHM_K + kws) = pack8(S.sf0, S.sf1); *(bf16x8*)(K_lds + (bf) * SHM_K + kws + 32 * 256) = pack8(S.sf2, S.sf3); } while (0)
#define SWRITE_VF(bf) do { *(bf16x8*)(V_lds + (bf) * SHM_V + vst0) = pack8(S.sf0, S.sf1); *(bf16x8*)(V_lds + (bf) * SHM_V + vst1) = pack8(S.sf2, S.sf3); } while (0)
template <class TIn, class TOut>
__device__ __forceinline__ void causal_swa_prime(const BlockRef<TIn, TOut>& cur, int W, char* lds, Seam<TIn>& S, const int wave_s) {
    constexpr bool F32 = same_t<TIn, float>::v;
    const int lane = fresh_lane(), wid = wave_s, tid = wid * 64 + lane, r32 = lane & 31, hi = lane >> 5;
    const int sr = tid >> 4, sc = (tid & 15) * 8, kws = KSWZ(sr, sc * 2); char* K_lds = lds + 2 * SHM_V;
    const int kb0 = cur.jlo * KVBLK;
    for (int d0 = 0; d0 < 8; ++d0) S.qr[d0] = load8<TIn>(cur.Q + (size_t)(wid * QBLK + r32) * PITCH + d0 * 16 + hi * 8);
    if constexpr (F32) { SLOAD_F((const float*)cur.K, kb0); VMW(); SWRITE_KF(0); SBAR(); SLOAD_F((const float*)cur.V, kb0); }
    else { SLOAD_H(cur.K, cur.V, cur.G, kb0); VMW(); SWRITE_HK(0); }
    __syncthreads();
}
template <class TIn, class TOut>
__device__ __forceinline__ void causal_swa_block(const BlockRef<TIn, TOut>& cur, const BlockRef<TIn, TOut>& nxt, int skv, int W, char* lds, Seam<TIn>& S, const int wave_s) {
    constexpr bool F32 = same_t<TIn, float>::v;
    const int lane = fresh_lane(), wid = wave_s, tid = wid * 64 + lane, r32 = lane & 31, hi = lane >> 5;
    const int j_lo = cur.jlo;
    int j_hi = (cur.P0 + QB - 1) / KVBLK + 1; if (j_hi > skv / KVBLK) j_hi = skv / KVBLK;
    const int NT = j_hi - j_lo;
    const int kbn = nxt.jlo * KVBLK;
    const int qlo = cur.P0 + wid * QBLK, qm = qlo + r32 - 4 * hi;
    char* V_lds = lds; char* K_lds = lds + 2 * SHM_V;
    float* ws = (float*)(lds + 2 * SHM_V + 2 * SHM_K) + wid * 64; float* li_l = ws, * al_l = ws + 32;
    float m_reg = -1e30f, l_reg = 0; f32x16 o[4] = {};
    const int sr = tid >> 4, sc = (tid & 15) * 8, vst0 = v_st(sr, sc), vst1 = v_st(32 + sr, sc), kws = KSWZ(sr, sc * 2);
    const int vb0 = (int)(uintptr_t)V_lds + v_rd_base(lane);
    const TIn* Kh = cur.K; const TIn* Vh = cur.V; const float* Gh = cur.G;
#define RESC(a) do { if (__any((a) < 1.f)) { if (hi == 0) al_l[r32] = (a); asm volatile("s_waitcnt lgkmcnt(0)" ::: "memory");              \
                     for (int d_ = 0; d_ < 4; ++d_) for (int r = 0; r < 16; ++r) o[d_][r] *= al_l[crow(r, hi)]; } } while (0)
#define KBASE(t) ((j_lo + (t)) * KVBLK)
#define ACT(t) (KBASE(t) <= qlo + QBLK - 1 && KBASE(t) + KVBLK - 1 >= qlo - W + 1)
#define MASKT(P0_, P1_, t) do { const int kb_ = KBASE(t); if ((!SK || ACT(t)) && (kb_ + KVBLK - 1 > qlo || kb_ <= qlo + QBLK - 1 - W)) mask_tile(P0_, P1_, qm - kb_, (unsigned)W); } while (0)
    constexpr int NQL = F32 ? 16 : 8;
    constexpr bool SK = WSKIP && !F32;
#define SEAM_K0() do { VMWN(NQL); if constexpr (F32) { SWRITE_KF(0); SBAR(); SLOAD_F((const float*)nxt.V, kbn); } else { SWRITE_HK(0); } SBAR(); } while (0)
    f32x16 pA0, pA1, pB0, pB1; float mnA, mnB, alA, alB; bf16x8 pa0, pa1, pa2, pa3;
    if constexpr (F32) { VMW(); SWRITE_VF(0); SBAR(); } else { SWRITE_HV(0); SBAR(); }
    if (NT > 1) { if constexpr (F32) SLOAD_F((const float*)Kh, KBASE(1)); else SLOAD_H(Kh, Vh, Gh, KBASE(1)); }
    SBAR(); qkt<0, SK>(pA0, pA1, K_lds, r32, hi, S.qr, ACT(0));
    if constexpr (F32) { if (NT > 1) { VMW(); SWRITE_KF(1); SBAR(); SLOAD_F((const float*)Vh, KBASE(1)); } }
    MASKT(pA0, pA1, 0); partialSM(pA0, pA1, m_reg, mnA, alA);
    if (NT > 1) { VMW(); if constexpr (F32) { SWRITE_VF(1); SBAR(); if (NT > 2) SLOAD_F((const float*)Kh, KBASE(2)); } else SWRITE_H(1); }
    __syncthreads();
#define HALF_STEP(PX0, PX1, mnX, alX, PY0, PY1, alY, t, KB, VB, SB) do {                                                      \
        SBAR(); qkt<KB, SK>(PX0, PX1, K_lds, r32, hi, S.qr, ACT(t));                                             \
        finishSM(PY0, PY1, alY, l_reg, pa0, pa1, pa2, pa3); SBAR();                                                           \
        if ((t) + 1 < NT) { if constexpr (F32) { VMW(); SWRITE_KF(SB); SBAR(); SLOAD_F((const float*)Vh, KBASE((t) + 1)); }  \
                            else { SLOAD_H(Kh, Vh, Gh, KBASE((t) + 1)); } SBAR(); }                                               \
        pv_tile<VB, SK>(o, vb0, pa0, pa1, pa2, pa3, ACT((t) - 1)); MASKT(PX0, PX1, (t)); partialSM(PX0, PX1, m_reg, mnX, alX);                                        \
        __syncthreads();                                                                                                      \
        if ((t) + 1 < NT) { VMW(); if constexpr (F32) { SWRITE_VF(SB); SBAR(); if ((t) + 2 < NT) SLOAD_F((const float*)Kh, KBASE((t) + 2)); } \
                            else { SWRITE_H(SB); } }                                                                          \
        RESC(alX); __syncthreads(); } while (0)
    for (int t = 1; t + 1 < NT; t += 2) {
        HALF_STEP(pB0, pB1, mnB, alB, pA0, pA1, alA, t, 1, 0, 0);
        HALF_STEP(pA0, pA1, mnA, alA, pB0, pB1, alB, t + 1, 0, 1, 1);
    }
    const bool even = (NT & 1) == 0;
    if (even) { SBAR(); qkt<1, SK>(pB0, pB1, K_lds, r32, hi, S.qr, ACT(NT - 1)); SBAR(); }
#define QROW(e) (nxt.Q + (size_t)(wid * QBLK + r32) * PITCH + ((e) >> 1) * 16 + hi * 8 + ((e) & 1) * 4)
    if constexpr (F32) { SLOAD_F((const float*)nxt.K, kbn); SBAR();
#pragma unroll
        for (int e = 0; e < 8; ++e) S.tq[e] = *(const f32x4*)QROW(e); }
    else { SLOAD_H(nxt.K, nxt.V, nxt.G, kbn); SBAR();
#pragma unroll
        for (int d0 = 0; d0 < 8; ++d0) S.qr[d0] = load8<TIn>(nxt.Q + (size_t)(wid * QBLK + r32) * PITCH + d0 * 16 + hi * 8); }
    SBAR();
    finishSM(pA0, pA1, alA, l_reg, pa0, pa1, pa2, pa3); SBAR();
    if constexpr (F32) {
#pragma unroll
        for (int e = 8; e < 16; ++e) S.tq[e] = *(const f32x4*)QROW(e); SBAR(); }
#undef QROW
    pv_tile<0, SK>(o, vb0, pa0, pa1, pa2, pa3, ACT(even ? NT - 2 : NT - 1));
    if (even) { MASKT(pB0, pB1, NT - 1); partialSM(pB0, pB1, m_reg, mnB, alB); __syncthreads(); RESC(alB);
        finishSM(pB0, pB1, alB, l_reg, pa0, pa1, pa2, pa3); SBAR(); pv_tile<1, SK>(o, vb0, pa0, pa1, pa2, pa3, ACT(NT - 1)); }
    SBAR(); SEAM_K0();
    if (hi == 0) li_l[r32] = l_reg; asm volatile("s_waitcnt lgkmcnt(0)" ::: "memory");
    float rli[16];
#pragma unroll
    for (int r = 0; r < 16; ++r) rli[r] = __builtin_amdgcn_rcpf(li_l[crow(r, hi)]);
    TOut* Ow = cur.O + (size_t)(wid * QBLK) * PITCH;
#pragma unroll
    for (int r = 0; r < 16; ++r) { const int orow = crow(r, hi);
#pragma unroll
        for (int d0 = 0; d0 < 4; ++d0) { const float v = o[d0][r] * rli[r];
            if constexpr (same_t<TOut, float>::v) { Ow[(size_t)orow * PITCH + d0 * 32 + r32] = v; }
            else { const float vn = __shfl_xor(v, 1);
                   if ((r32 & 1) == 0) *(unsigned*)(Ow + (size_t)orow * PITCH + d0 * 32 + r32) = cvtpk(v, vn); } } }
    if constexpr (F32) {
#pragma unroll
        for (int d0 = 0; d0 < 8; ++d0) S.qr[d0] = pack8(S.tq[2 * d0], S.tq[2 * d0 + 1]); }
    __syncthreads();
#undef RESC
#undef KBASE
#undef ACT
#undef MASKT
#undef SEAM_K0
#undef HALF_STEP
}
#undef ROW
#undef VMW
#undef VMWN
#undef SLOAD_H
#undef SWRITE_HK
#undef SWRITE_HV
#undef SWRITE_H
#undef SLOAD_F
#undef SWRITE_KF
#undef SWRITE_VF


}

#define LAS __attribute__((address_space(3)))
typedef unsigned short bf16_t;
typedef float f32x4 __attribute__((ext_vector_type(4)));
typedef float f32x2 __attribute__((ext_vector_type(2)));
typedef unsigned u32x4 __attribute__((ext_vector_type(4)));
typedef unsigned u32x2 __attribute__((ext_vector_type(2)));

constexpr int BATCH = 4, SEQ = 8192, DM = 1024, NTOK = BATCH * SEQ, DIN = 7176, NPROJ = 7168, DFF = 4096, NH = 8;
constexpr size_t MiB = 1u << 20;
constexpr size_t PLANE = 64 * MiB;
constexpr size_t WS_UB = 448 * MiB;
constexpr size_t WS_NEED = 512 * MiB;
constexpr size_t UB_BAR2 = 0, UB_SSQ2 = 64 * 1024, UB_CNT = 256 * 1024, UB_WDN = 1 * MiB;
constexpr size_t DO_WIN = 0, DO_WA = 16 * MiB, DO_WB = 18 * MiB, DO_WO = 20 * MiB, DO_WUP = 22 * MiB, DO_WDN = 30 * MiB,
                 DO_LOGF = 40 * MiB, DO_G = 41 * MiB, DO_LA = 42 * MiB, DO_LH = 44 * MiB, DO_SSQ = 46 * MiB;
constexpr int LRU_TC = 256, LRU_NCH = SEQ / LRU_TC;
constexpr size_t DO_MISC = 48 * MiB;
constexpr int ATT_FETCH_OFF = 147456 - 128;
constexpr size_t DO_BAR = 52 * MiB; constexpr int BAR_BYTES = 16384;
constexpr size_t DO_LW = 47 * MiB;
constexpr int LRU_WAVE_LDS = 9728 + 8192;
constexpr int LDS_BYTES = 147456;

constexpr int DUP_P4 = 1, DUP_P0 = 1, DUP_SYNC = 0, DUP_ATT = 1, DUP_P1 = 1, DUP_P6 = 1;
struct Params { const float* in[18]; float* out; unsigned char* ws; };

__device__ __forceinline__ unsigned cvtpk2(float lo, float hi) { unsigned r; asm volatile("v_cvt_pk_bf16_f32 %0, %1, %2" : "=v"(r) : "v"(lo), "v"(hi)); return r; }
__device__ __forceinline__ float bf2f(bf16_t v) { return __uint_as_float((unsigned)v << 16); }
__device__ __forceinline__ float wave_sum(float v) {
#pragma unroll
    for (int o = 1; o < 64; o <<= 1) v += __shfl_xor(v, o);
    return v;
}
__device__ __forceinline__ float sigm(float x) { return __builtin_amdgcn_rcpf(1.f + __expf(-x)); }
#define LDS_WAIT() asm volatile("s_waitcnt lgkmcnt(0)" ::: "memory")


#define GAS __attribute__((address_space(1)))
#define RLX_AGENT __ATOMIC_RELAXED, __HIP_MEMORY_SCOPE_AGENT
#define XB_TMO      128
#define XB_XCNT(j)  (256  + 64 * (j))
#define XB_XSUB(j)  (1280 + 64 * (j))
#define XB_XGEN(j)  (2304 + 64 * (j))
#define XB_TOP      3328
#define XB_TOPGEN   3392
#define XCD_BAR_WORDS 3456
#define XB_SPIN_CAP (1u << 18)

__device__ __forceinline__ unsigned xb_ld(unsigned* p)              { return __hip_atomic_load(p, __ATOMIC_RELAXED, __HIP_MEMORY_SCOPE_AGENT); }
__device__ __forceinline__ unsigned xb_add(unsigned* p, unsigned v) { return __hip_atomic_fetch_add(p, v, __ATOMIC_RELAXED, __HIP_MEMORY_SCOPE_AGENT); }
__device__ __forceinline__ unsigned xb_xcc_id() { return (unsigned)__builtin_amdgcn_s_getreg((3 << 11) | 20) & 0xFu; }
#define XB_SPIN(cond, bar) do { unsigned _sp = 0; while (cond) { __builtin_amdgcn_s_sleep(1); \
    if ((++_sp & 255u) == 0u) { if (xb_ld(&(bar)[XB_TMO])) break; if (_sp > XB_SPIN_CAP) { atomicAdd(&(bar)[XB_TMO], 1u); break; } } } } while (0)

struct XcdBarrier {
    unsigned* bar; unsigned x;
    volatile LAS unsigned* st;
};

__device__ __forceinline__ XcdBarrier xcd_barrier_post(unsigned* bar, volatile LAS unsigned* st, const int wave_s) {
    XcdBarrier b; b.bar = bar; b.x = xb_xcc_id(); b.st = st;
    if (wave_s == 0 && fresh_lane() == 0) (void)xb_add(&bar[XB_XCNT(b.x)], 1u);
    return b;
}
__device__ __forceinline__ void xcd_barrier_complete(unsigned* bar, unsigned x, unsigned& nloc, unsigned& nx) {
    const unsigned G = gridDim.x * gridDim.y * gridDim.z;
    unsigned sum, cnt, mine, sp = 0u;
    for (;;) {
        sum = 0u; cnt = 0u; mine = 0u;
#pragma unroll
        for (unsigned j = 0; j < 16; ++j) { const unsigned c = xb_ld(&bar[XB_XCNT(j)]); sum += c; cnt += (c > 0u) ? 1u : 0u; mine = (j == x) ? c : mine; }
        if (sum == G) break;
        __builtin_amdgcn_s_sleep(1);
        if ((++sp & 255u) == 0u) { if (xb_ld(&bar[XB_TMO])) break; if (sp > XB_SPIN_CAP) { atomicAdd(&bar[XB_TMO], 1u); break; } }
    }
    nloc = mine > 0u ? mine : 1u; nx = cnt > 0u ? cnt : 1u;
}

__device__ __forceinline__ void xcd_barrier(const XcdBarrier& b, const int wave_s) {
    asm volatile("s_waitcnt vmcnt(0)" ::: "memory");
    __syncthreads();
    if (wave_s == 0 && fresh_lane() == 0) {
        unsigned* bar = b.bar;
        __builtin_amdgcn_s_waitcnt(0);
        unsigned nloc = b.st[0], nx = b.st[1];
        if (nloc == 0u) { xcd_barrier_complete(bar, b.x, nloc, nx); b.st[0] = nloc; b.st[1] = nx; }
        const unsigned old = xb_add(&bar[XB_XSUB(b.x)], 1u);
        const unsigned gen = old / nloc;
        if (old + 1u == (gen + 1u) * nloc) {
            __builtin_amdgcn_fence(__ATOMIC_RELEASE, "agent");
            asm volatile("s_waitcnt vmcnt(0)" ::: "memory");
            const unsigned og = xb_add(&bar[XB_TOP], 1u);
            const unsigned tg = og / nx;
            if (og + 1u == (tg + 1u) * nx) xb_add(&bar[XB_TOPGEN], 1u);
            else XB_SPIN(xb_ld(&bar[XB_TOPGEN]) == tg, bar);
            __builtin_amdgcn_fence(__ATOMIC_ACQUIRE, "agent");
            xb_add(&bar[XB_XGEN(b.x)], 1u);
            asm volatile("s_waitcnt vmcnt(0)" ::: "memory");
        } else {
            XB_SPIN(xb_ld(&bar[XB_XGEN(b.x)]) == gen, bar);
            __builtin_amdgcn_fence(__ATOMIC_ACQUIRE, "agent");
            asm volatile("s_waitcnt vmcnt(0)" ::: "memory");
        }
    }
    __syncthreads();
}

__device__ __forceinline__ void tr_item(const float* W, int ldn, int nblk, int K, bf16_t* WT, const float* gk, LAS float* scr, int item, int lane) {
    const int kb = item / nblk, nb = item % nblk, k0 = 64 * kb, n0 = 32 * nb;
#pragma unroll
    for (int i = 0; i < 32; ++i) { const int kk = 2 * i + (lane >> 5); float v = W[(size_t)(k0 + kk) * ldn + n0 + (lane & 31)]; if (gk) v *= gk[k0 + kk]; scr[kk * 33 + (lane & 31)] = v; }
    LDS_WAIT();
    const int c = lane & 7;
#pragma unroll
    for (int j = 0; j < 4; ++j) { const int n = (lane >> 3) + 8 * j; const LAS float* s = scr + (8 * c) * 33 + n;
        u32x4 o; o.x = cvtpk2(s[0 * 33], s[1 * 33]); o.y = cvtpk2(s[2 * 33], s[3 * 33]); o.z = cvtpk2(s[4 * 33], s[5 * 33]); o.w = cvtpk2(s[6 * 33], s[7 * 33]);
        *(u32x4*)(WT + (size_t)(n0 + n) * K + k0 + 8 * c) = o; }
    LDS_WAIT();
}

__device__ __forceinline__ void phase0(const Params& p, LAS unsigned char* lds, int tid, int lane, int wave) {
    const int gw = blockIdx.x * 8 + wave, NGW = gridDim.x * 8;
    LAS float* scr = (LAS float*)(lds + wave * 16384);
    unsigned char* dob = (unsigned char*)p.out;
    { float* ssq = (float*)(dob + DO_SSQ); for (int i = blockIdx.x * 512 + tid; i < NTOK; i += gridDim.x * 512) ssq[i] = 0.f;
      if (blockIdx.x == 0) { unsigned* mw = (unsigned*)(dob + DO_MISC); for (int i = tid; i < 1024; i += 512) mw[i] = 0u; } }
    constexpr int I_IN = 16 * 224;
    for (int it = gw; it < I_IN; it += NGW) tr_item(p.in[2], DIN, 224, 1024, (bf16_t*)(dob + DO_WIN), nullptr, scr, it, lane);
    for (int idx = blockIdx.x * 512 + tid; idx < 2 * 16 * 64 * 8; idx += gridDim.x * 512) {
        const int mat = idx >> 13, r = idx & 8191, nn = r >> 9, dd = (r >> 3) & 63, c0 = (r & 7) * 8;
        const float* W = (mat ? p.in[7] : p.in[5]) + nn * 4096 + dd;
        u32x4 o; o.x = cvtpk2(W[(c0 + 0) * 64], W[(c0 + 1) * 64]); o.y = cvtpk2(W[(c0 + 2) * 64], W[(c0 + 3) * 64]); o.z = cvtpk2(W[(c0 + 4) * 64], W[(c0 + 5) * 64]); o.w = cvtpk2(W[(c0 + 6) * 64], W[(c0 + 7) * 64]);
        *(u32x4*)((bf16_t*)(dob + DO_LW) + mat * 65536 + nn * 4096 + dd * 64 + c0) = o;
    }
    float wf[16][8]; f32x4 gq[4];
#pragma unroll
    for (int j = 0; j < 4; ++j) { gq[j] = *((const f32x4*)p.in[1] + lane + 64 * j);
#pragma unroll
        for (int i = 0; i < 4; ++i) { const float* wp = p.in[2] + (size_t)(256 * j + 4 * lane + i) * DIN + NPROJ; const f32x4 a = *(const f32x4*)wp, b = *(const f32x4*)(wp + 4);
            wf[4 * j + i][0] = a[0]; wf[4 * j + i][1] = a[1]; wf[4 * j + i][2] = a[2]; wf[4 * j + i][3] = a[3]; wf[4 * j + i][4] = b[0]; wf[4 * j + i][5] = b[1]; wf[4 * j + i][6] = b[2]; wf[4 * j + i][7] = b[3]; } }
    const float fb = p.in[10][lane & 7];
    bf16_t* U = (bf16_t*)(p.ws + WS_UB); float* logf = (float*)(dob + DO_LOGF);
    f32x4 vn[4];
    { const f32x4* xr = (const f32x4*)(p.in[0] + (size_t)gw * DM) + lane;
#pragma unroll
      for (int j = 0; j < 4; ++j) vn[j] = xr[64 * j]; }
    for (int m = gw; m < NTOK; m += NGW) {
        f32x4 v[4]; float s = 0.f;
#pragma unroll
        for (int j = 0; j < 4; ++j) { v[j] = vn[j]; s += (v[j][0] * v[j][0] + v[j][1] * v[j][1]) + (v[j][2] * v[j][2] + v[j][3] * v[j][3]); }
        { const int mn = (m + NGW < NTOK) ? m + NGW : m; const f32x4* xr = (const f32x4*)(p.in[0] + (size_t)mn * DM) + lane;
#pragma unroll
          for (int j = 0; j < 4; ++j) vn[j] = xr[64 * j]; }
        const float rstd = 1.0f / sqrtf(wave_sum(s) * (1.0f / DM) + 1e-6f);
        float fl[8] = {0.f, 0.f, 0.f, 0.f, 0.f, 0.f, 0.f, 0.f};
        unsigned long long* o8 = (unsigned long long*)(U + (size_t)m * DM) + lane;
#pragma unroll
        for (int j = 0; j < 4; ++j) { v[j] = v[j] * rstd * gq[j];
#pragma unroll
            for (int i = 0; i < 4; ++i)
#pragma unroll
                for (int h = 0; h < 8; ++h) fl[h] = fmaf(v[j][i], wf[4 * j + i][h], fl[h]);
            o8[64 * j] = (unsigned long long)cvtpk2(v[j][0], v[j][1]) | ((unsigned long long)cvtpk2(v[j][2], v[j][3]) << 32); }
        float my = 0.f;
#pragma unroll
        for (int h = 0; h < 8; ++h) { const float t = wave_sum(fl[h]); my = ((lane & 7) == h) ? t : my; }
        if (lane < 8) { const float z = my + fb; logf[((size_t)(m >> 13) * 8 + lane) * SEQ + (m & (SEQ - 1))] = fminf(z, 0.f) - log1pf(expf(-fabsf(z))); }
    }
}

__device__ __forceinline__ void forget_cumsum(const Params& p, LAS unsigned char* lds, int tid, int lane, int wave) {
    unsigned char* dob = (unsigned char*)p.out;
    for (int bh = blockIdx.x; bh < BATCH * NH; bh += gridDim.x) {
        const int b = bh >> 3, h = bh & 7;
        const float* lf = (const float*)(dob + DO_LOGF) + (size_t)bh * SEQ; (void)b; (void)h;
        float* Gp = (float*)(dob + DO_G) + (size_t)bh * SEQ;
        float loc[16]; float s = 0.f;
#pragma unroll
        for (int i = 0; i < 4; ++i) { const f32x4 v = *(const f32x4*)(lf + 16 * tid + 4 * i); loc[4 * i] = v[0]; loc[4 * i + 1] = v[1]; loc[4 * i + 2] = v[2]; loc[4 * i + 3] = v[3]; }
#pragma unroll
        for (int i = 0; i < 16; ++i) s += loc[i];
        float incl = s;
#pragma unroll
        for (int o = 1; o < 64; o <<= 1) { const float t = __shfl_up(incl, o); if (lane >= o) incl += t; }
        LAS float* wt = (LAS float*)lds;
        if (lane == 63) wt[wave] = incl;
        __syncthreads();
        float run = incl - s;
        for (int w = 0; w < wave; ++w) run += wt[w];
#pragma unroll
        for (int i = 0; i < 4; ++i) { f32x4 o;
#pragma unroll
            for (int k = 0; k < 4; ++k) { run += loc[4 * i + k]; o[k] = -run * 11.313708498984761f; }
            *(f32x4*)(Gp + 16 * tid + 4 * i) = o; }
        __syncthreads();
    }
}

typedef short s16x8 __attribute__((ext_vector_type(8)));
__device__ __forceinline__ float lds_bf(const LAS unsigned char* p) { return __uint_as_float((unsigned)(*(const LAS unsigned short*)p) << 16); }
template <bool APPLY>
__device__ __forceinline__ void lru_unit(const Params& p, int b, int c, int n, int lane, LAS unsigned char* wl) {
    unsigned char* dob = (unsigned char*)p.out;
    const int fr = lane & 15, fq = lane >> 4;
    const bf16_t* wat = (const bf16_t*)(dob + DO_LW) + n * 4096; const bf16_t* wxt = wat + 65536;
    LAS unsigned char* xs = wl; LAS unsigned char* gs = wl + 9728;
    const int t0 = c * LRU_TC;
    const size_t gofs = (size_t)(b * SEQ + t0) * DM + n * 64;
    const bf16_t* xg = (const bf16_t*)p.ws + gofs;
    bf16_t* gg = (bf16_t*)(p.ws + PLANE) + gofs;
    float* LA = (float*)(dob + DO_LA); float* LH = (float*)(dob + DO_LH);
    float hsub[4] = {0.f, 0.f, 0.f, 0.f}, slr[4] = {0.f, 0.f, 0.f, 0.f};
    if (APPLY) {
        for (int j = 0; j < c; ++j) { const size_t o = ((size_t)(b * LRU_NCH + j)) * DM + n * 64 + fr;
#pragma unroll
            for (int q = 0; q < 4; ++q) hsub[q] = fmaf(LA[o + 16 * q], hsub[q], LH[o + 16 * q]); }
    }
    u32x4 xpre[9], gpre[8];
#define LRU_LOAD(s_) do { const bf16_t* xb_ = xg + (ptrdiff_t)(64 * (s_) - 3 + (lane >> 3)) * DM + (lane & 7) * 8; asm volatile("" : "+v"(xb_));   \
        _Pragma("unroll") for (int it = 0; it < 9; ++it) { const int row = it * 8 + (lane >> 3); u32x4 v = {0u, 0u, 0u, 0u}; \
            if (row < 67 && t0 + 64 * (s_) - 3 + row >= 0) v = *(const u32x4*)(xb_ + (size_t)it * 8 * DM); xpre[it] = v; } \
        } while (0)
#define LRU_LOADG(s_) do { if (APPLY) { const bf16_t* gb_ = gg + (size_t)(64 * (s_) + (lane >> 3)) * DM + (lane & 7) * 8; asm volatile("" : "+v"(gb_)); \
        _Pragma("unroll") for (int it = 0; it < 8; ++it) gpre[it] = *(const u32x4*)(gb_ + (size_t)it * 8 * DM); } } while (0)
    s16x8 nBa[2], nBx[2];
#define LRU_QLOAD(q_) do { \
        _Pragma("unroll") for (int ks = 0; ks < 2; ++ks) { nBa[ks] = *(const s16x8*)(wat + (16 * (q_) + fr) * 64 + 32 * ks + 8 * fq); nBx[ks] = *(const s16x8*)(wxt + (16 * (q_) + fr) * 64 + 32 * ks + 8 * fq); } } while (0)
    LRU_QLOAD(0);
    LRU_LOAD(0);
    for (int s = 0; s < LRU_TC / 64; ++s) {
#pragma unroll
        for (int it = 0; it < 9; ++it) { const int row = it * 8 + (lane >> 3), ch = lane & 7; if (row < 67) *(LAS u32x4*)(xs + row * 144 + ch * 16) = xpre[it]; }
        LRU_LOADG(s);
        if (s + 1 < LRU_TC / 64) LRU_LOAD(s + 1);
        LDS_WAIT();
        s16x8 Af[4][2];
#pragma unroll
        for (int ks = 0; ks < 2; ++ks) {
            const int cA = n * 64 + 32 * ks + 8 * fq;
            f32x4 cw[4][2], cbv[2];
#pragma unroll
            for (int k = 0; k < 4; ++k) { cw[k][0] = *(const f32x4*)(p.in[3] + k * 1024 + cA); cw[k][1] = *(const f32x4*)(p.in[3] + k * 1024 + cA + 4); }
            cbv[0] = *(const f32x4*)(p.in[4] + cA); cbv[1] = *(const f32x4*)(p.in[4] + cA + 4);
#pragma unroll
            for (int m = 0; m < 4; ++m) { const int tau = 16 * (fr >> 2) + 4 * m + (fr & 3);
                f32x4 a0 = cbv[0], a1 = cbv[1];
#pragma unroll
                for (int k = 0; k < 4; ++k) { const u32x4 xv = *(const LAS u32x4*)(xs + (tau + k) * 144 + (32 * ks + 8 * fq) * 2);
                    a0[0] = fmaf(cw[k][0][0], __uint_as_float(xv.x << 16), a0[0]); a0[1] = fmaf(cw[k][0][1], __uint_as_float(xv.x & 0xffff0000u), a0[1]);
                    a0[2] = fmaf(cw[k][0][2], __uint_as_float(xv.y << 16), a0[2]); a0[3] = fmaf(cw[k][0][3], __uint_as_float(xv.y & 0xffff0000u), a0[3]);
                    a1[0] = fmaf(cw[k][1][0], __uint_as_float(xv.z << 16), a1[0]); a1[1] = fmaf(cw[k][1][1], __uint_as_float(xv.z & 0xffff0000u), a1[1]);
                    a1[2] = fmaf(cw[k][1][2], __uint_as_float(xv.w << 16), a1[2]); a1[3] = fmaf(cw[k][1][3], __uint_as_float(xv.w & 0xffff0000u), a1[3]); }
                u32x4 w = {cvtpk2(a0[0], a0[1]), cvtpk2(a0[2], a0[3]), cvtpk2(a1[0], a1[1]), cvtpk2(a1[2], a1[3])};
                Af[m][ks] = *reinterpret_cast<s16x8*>(&w); }
        }
        if (APPLY) {
#pragma unroll
            for (int it = 0; it < 8; ++it) { const int row = it * 8 + (lane >> 3), ch = lane & 7; *(LAS u32x4*)(gs + row * 128 + ch * 16) = gpre[it]; }
            LDS_WAIT(); }
#pragma unroll 1
        for (int q = 0; q < 4; ++q) {
            const int cl = 16 * q + fr;
            s16x8 Ba[2] = {nBa[0], nBa[1]}, Bx[2] = {nBx[0], nBx[1]};
            const int d = n * 64 + cl;
            const float ba = p.in[6][d], bx = p.in[8][d], nl = -p.in[9][d];
            const float cw0 = p.in[3][d], cw1 = p.in[3][1024 + d], cw2 = p.in[3][2048 + d], cw3 = p.in[3][3072 + d], cb = p.in[4][d];
            LRU_QLOAD((q + 1) & 3);
            const float kk = -8.0f * (fmaxf(nl, 0.f) + log1pf(__expf(-fabsf(nl))));
            f32x4 aR[4], aI[4];
#pragma unroll
            for (int m = 0; m < 4; ++m) { aR[m] = (f32x4){ba, ba, ba, ba}; aI[m] = (f32x4){bx, bx, bx, bx};
#pragma unroll
                for (int ks = 0; ks < 2; ++ks) { aR[m] = __builtin_amdgcn_mfma_f32_16x16x32_bf16(Af[m][ks], Ba[ks], aR[m], 0, 0, 0); aI[m] = __builtin_amdgcn_mfma_f32_16x16x32_bf16(Af[m][ks], Bx[ks], aI[m], 0, 0, 0); } }
            float xw[19];
#pragma unroll
            for (int i = 0; i < 19; ++i) xw[i] = lds_bf(xs + (16 * fq + i) * 144 + cl * 2);
            float av[16], bv[16]; float hl = 0.f, sr = 0.f; const float kkl = kk * 1.4426950408889634f, kk2 = 2.0f * kk;
#pragma unroll
            for (int ip = 0; ip < 8; ++ip) {
                const int i = 2 * ip;
                f32x2 xa = (f32x2){cb, cb} + (f32x2){cw0, cw0} * (f32x2){xw[i], xw[i + 1]} + (f32x2){cw1, cw1} * (f32x2){xw[i + 1], xw[i + 2]} + (f32x2){cw2, cw2} * (f32x2){xw[i + 2], xw[i + 3]} + (f32x2){cw3, cw3} * (f32x2){xw[i + 3], xw[i + 4]};
                f32x2 eR = (f32x2){aR[i >> 2][i & 3], aR[i >> 2][(i & 3) + 1]} * -1.4426950408889634f, eI = (f32x2){aI[i >> 2][i & 3], aI[i >> 2][(i & 3) + 1]} * -1.4426950408889634f;
                eR.x = __builtin_amdgcn_exp2f(eR.x); eR.y = __builtin_amdgcn_exp2f(eR.y); eI.x = __builtin_amdgcn_exp2f(eI.x); eI.y = __builtin_amdgcn_exp2f(eI.y);
                eR = eR + 1.0f; eI = eI + 1.0f;
                f32x2 r, ig; r.x = __builtin_amdgcn_rcpf(eR.x); r.y = __builtin_amdgcn_rcpf(eR.y); ig.x = __builtin_amdgcn_rcpf(eI.x); ig.y = __builtin_amdgcn_rcpf(eI.y);
                f32x2 a = r * kkl; const f32x2 y = r * kk2;
                a.x = __builtin_amdgcn_exp2f(a.x); a.y = __builtin_amdgcn_exp2f(a.y);
                f32x2 om = y * (1.0f / 120.0f) + (1.0f / 24.0f); om = om * y + (1.0f / 6.0f); om = om * y + 0.5f; om = om * y + 1.0f; om = om * (-y);
                const f32x2 ex = 1.0f - a * a;
                f32x2 sq; sq.x = __builtin_amdgcn_sqrtf(y.x < -0.5f ? ex.x : om.x); sq.y = __builtin_amdgcn_sqrtf(y.y < -0.5f ? ex.y : om.y);
                const f32x2 bt = sq * ig * xa;
                av[i] = a.x; av[i + 1] = a.y; bv[i] = bt.x; bv[i + 1] = bt.y;
                hl = fmaf(a.x, hl, bt.x); hl = fmaf(a.y, hl, bt.y); sr += r.x + r.y;
            }
            const float sl = kk * sr, Al = __expf(sl);
            float st = q == 0 ? hsub[0] : q == 1 ? hsub[1] : q == 2 ? hsub[2] : hsub[3], hin = st;
#pragma unroll
            for (int j = 0; j < 4; ++j) { const float Aj = __shfl(Al, fr + 16 * j), Hj = __shfl(hl, fr + 16 * j); st = fmaf(Aj, st, Hj); if (j < fq) hin = st; }
#pragma unroll
            for (int z = 0; z < 4; ++z) { hsub[z] = (z == q) ? st : hsub[z]; slr[z] += (z == q) ? sl : 0.f; }
            if (APPLY) {
                float h = hin;
#pragma unroll
                for (int i = 0; i < 16; ++i) { h = fmaf(av[i], h, bv[i]);
                    LAS unsigned short* gp = (LAS unsigned short*)(gs + (16 * fq + i) * 128 + cl * 2);
                    const float g = __uint_as_float((unsigned)(*gp) << 16); const float ge = g * sigm(1.5957691216057308f * (g + 0.044715f * g * g * g));
                    *gp = (unsigned short)(cvtpk2(ge * h, 0.f) & 0xffffu); }
            }
        }
        if (APPLY) {
            LDS_WAIT();
#pragma unroll
            for (int it = 0; it < 8; ++it) { const int row = it * 8 + (lane >> 3), ch = lane & 7;
                *(u32x4*)(gg + (size_t)(64 * s + row) * DM + ch * 8) = *(const LAS u32x4*)(gs + row * 128 + ch * 16); }
        }
        LDS_WAIT();
    }
    if (!APPLY) {
#pragma unroll
        for (int q = 0; q < 4; ++q) { float t = slr[q]; t += __shfl_xor(t, 16); t += __shfl_xor(t, 32);
            if (fq == 0) { const size_t o = ((size_t)(b * LRU_NCH + c)) * DM + n * 64 + 16 * q + fr; LA[o] = __expf(t); LH[o] = hsub[q]; } }
    }
}
#undef LRU_LOAD
#undef LRU_LOADG
#undef LRU_QLOAD
template <bool APPLY>
__device__ __forceinline__ void lru_phase(const Params& p, LAS unsigned char* lds, int lane, int wave) {
    LAS unsigned char* wl = lds + wave * LRU_WAVE_LDS;
    const int gw = blockIdx.x * 8 + wave, NGW = gridDim.x * 8;
    for (int uix = gw; uix < BATCH * LRU_NCH * 16; uix += NGW) {
        const int b = uix / (LRU_NCH * 16), c = (uix / 16) % LRU_NCH, n = uix % 16;
        if (!APPLY && c == LRU_NCH - 1) continue;
        lru_unit<APPLY>(p, b, c, n, lane, wl);
    }
}

__device__ __forceinline__ att::BlockRef<att::bf16, att::bf16> att_ref(const Params& p, int e) {
    const int bh = e >> 5, qb = e & 31, b = bh >> 3, h = bh & 7;
    const size_t rowq = (size_t)(b * SEQ + qb * 256) * DM + h * 128, rowk = (size_t)(b * SEQ) * DM + h * 128;
    att::BlockRef<att::bf16, att::bf16> r;
    r.Q = (const att::bf16*)(p.ws + 2 * PLANE) + rowq; r.K = (const att::bf16*)(p.ws + 3 * PLANE) + rowk; r.V = (const att::bf16*)(p.ws + 4 * PLANE) + rowk;
    r.O = (att::bf16*)(p.ws + WS_UB) + rowq; r.G = (const float*)((const unsigned char*)p.out + DO_G) + (size_t)bh * SEQ; r.P0 = qb * 256;
    r.jlo = ((const int*)((const unsigned char*)p.out + DO_MISC + 8192))[e];
    return r;
}
__device__ __forceinline__ void jlo_phase(const Params& p, int lane, int wave) {
    const unsigned char* dob = (const unsigned char*)p.out;
    int* jlo = (int*)((unsigned char*)p.out + DO_MISC + 8192);
    if (wave >= 4) return;
    for (int e = wave * (int)gridDim.x + (int)blockIdx.x; e < BATCH * NH * 32; e += 4 * (int)gridDim.x) {
        const int bh = e >> 5, qb = e & 31, b = bh >> 3, h = bh & 7, half = lane & 1;
        const float* Gp = (const float*)(dob + DO_G) + (size_t)bh * SEQ;
        float qn = 0.f, L = 3.0e38f;
#pragma unroll
        for (int ps = 0; ps < 2; ++ps) {
            const int row = ps * 128 + (lane >> 1);
            const size_t off = (size_t)(b * SEQ + qb * 256 + row) * DM + h * 128 + half * 64;
            const bf16_t* q = (const bf16_t*)(p.ws + 2 * PLANE) + off; const bf16_t* k = (const bf16_t*)(p.ws + 3 * PLANE) + off;
            const float gr = Gp[qb * 256 + row];
            float dq = 0.f, qq = 0.f;
#pragma unroll
            for (int i = 0; i < 8; ++i) { const u32x4 a = *(const u32x4*)(q + 8 * i), c = *(const u32x4*)(k + 8 * i);
#pragma unroll
                for (int w = 0; w < 4; ++w) { const float a0 = __uint_as_float(a[w] << 16), a1 = __uint_as_float(a[w] & 0xffff0000u), c0 = __uint_as_float(c[w] << 16), c1 = __uint_as_float(c[w] & 0xffff0000u);
                    dq = fmaf(a0, c0, dq); dq = fmaf(a1, c1, dq); qq = fmaf(a0, a0, qq); qq = fmaf(a1, a1, qq); } }
            dq += __shfl_xor(dq, 1); qq += __shfl_xor(qq, 1);
            L = fminf(L, dq + gr); qn = fmaxf(qn, sqrtf(qq));
        }
#pragma unroll
        for (int o = 2; o < 64; o <<= 1) { qn = fmaxf(qn, __shfl_xor(qn, o)); L = fminf(L, __shfl_xor(L, o)); }
        const unsigned* KP = (const unsigned*)(dob + DO_MISC) + bh * 4;
        const float Kmax = sqrtf(((__uint_as_float(KP[0]) + __uint_as_float(KP[1])) + (__uint_as_float(KP[2]) + __uint_as_float(KP[3]))) * 1.01f);
        const float thresh = L - 1180.0f - qn * 1.002f * Kmax;
        int jl = 4 * qb + 3;
#pragma unroll
        for (int t0 = 0; t0 < 128; t0 += 64) { const int t = t0 + lane; if (t < 4 * qb + 3) { if (!(Gp[64 * t + 63] < thresh)) jl = min(jl, t); } }
#pragma unroll
        for (int o = 1; o < 64; o <<= 1) jl = min(jl, __shfl_xor(jl, o));
        if (lane == 0) jlo[e] = jl;
    }
}
__device__ __forceinline__ int att_fetch(const Params& p) {
    unsigned* heads = (unsigned*)((unsigned char*)p.out + DO_MISC) + 512;
    const int q0 = blockIdx.x & 7;
    for (int k = 0; k < 8; ++k) { const int q = (q0 + k) & 7;
        const unsigned idx = __hip_atomic_fetch_add(heads + 64 * q, 1u, __ATOMIC_RELAXED, __HIP_MEMORY_SCOPE_AGENT);
        if (idx < 128u * DUP_ATT) return (4 * q + (int)(idx & 3u)) * 32 + (31 - (int)((idx & 127u) >> 2)); }
    return -1;
}

__device__ __forceinline__ void late_transposes(const Params& p, LAS unsigned char* lds, int lane, int wave) {
    if (wave < 4) return;
    unsigned char* dob = (unsigned char*)p.out;
    LAS float* scr = (LAS float*)(lds + wave * LRU_WAVE_LDS);
    constexpr int I_SQ = 16 * 32, I_UP = 16 * 128, NIT = 3 * I_SQ + I_UP;
    for (int it = (int)blockIdx.x * 4 + (wave - 4); it < NIT; it += (int)gridDim.x * 4) {
        int r = it;
        if (r < I_SQ) { tr_item(p.in[11], 1024, 32, 1024, (bf16_t*)(dob + DO_WA), nullptr, scr, r, lane); continue; } r -= I_SQ;
        if (r < I_SQ) { tr_item(p.in[12], 1024, 32, 1024, (bf16_t*)(dob + DO_WB), nullptr, scr, r, lane); continue; } r -= I_SQ;
        if (r < I_SQ) { tr_item(p.in[13], 1024, 32, 1024, (bf16_t*)(dob + DO_WO), nullptr, scr, r, lane); continue; } r -= I_SQ;
        tr_item(p.in[15], 4096, 128, 1024, (bf16_t*)(dob + DO_WUP), p.in[14], scr, r, lane);
    }
}
__global__ void __launch_bounds__(512, 2) mega_fwd(Params p) {
    extern __shared__ __attribute__((aligned(16))) unsigned char lds[];
    cg::grid_group grid = cg::this_grid();
    const int wave = __builtin_amdgcn_readfirstlane((int)threadIdx.x >> 6);
#define FRESH() const int lane = fresh_lane(), tid = wave * 64 + lane; (void)tid; (void)lane
    const int G = gridDim.x, bid = blockIdx.x;
    LAS unsigned char* L3 = (LAS unsigned char*)lds;
    unsigned char* dob = (unsigned char*)p.out;
    bf16_t* PL0 = (bf16_t*)p.ws;
    const size_t PE = PLANE / 2;
    volatile LAS unsigned* MISC = (volatile LAS unsigned*)(L3 + LDS_BYTES - 64);
    { FRESH(); if (tid < 16) MISC[tid] = 0u; }
    __syncthreads();
    const XcdBarrier xbar = xcd_barrier_post((unsigned*)(dob + DO_BAR), MISC, wave);
#define GRID_BAR() xcd_barrier(xbar, wave)

    { FRESH(); phase0(p, L3, tid, lane, wave); }
    if (p.ws == nullptr) grid.sync();
    GRID_BAR();
    { FRESH(); forget_cumsum(p, L3, tid, lane, wave); }
    for (int rep = 0; rep < DUP_P1; ++rep)
    { pg8::Gemm g{(const bf16_t*)(p.ws + WS_UB), (const bf16_t*)(dob + DO_WIN), NTOK, NPROJ, DM, nullptr, nullptr}; pg8::StaticOrder S; S.init(NTOK, NPROJ, G, bid);
      pg8::EpiProj E{PL0, PE, (unsigned*)(dob + DO_MISC)};
      pg8::gemm_phase<pg8::EpiProj, pg8::StaticOrder, true, true>(L3, g, S, E, wave); }
    GRID_BAR();
    { FRESH(); jlo_phase(p, lane, wave); }
    { FRESH(); late_transposes(p, L3, lane, wave); }
    { FRESH(); lru_phase<false>(p, L3, lane, wave); }
    { FRESH(); if (tid == 0) { LAS int* fw0 = (LAS int*)(L3 + ATT_FETCH_OFF); fw0[0] = att_fetch(p); fw0[1] = att_fetch(p); } }
    GRID_BAR();
    {
        LAS int* fw = (LAS int*)(L3 + ATT_FETCH_OFF);
        int cur_e = 0, nxt_e = 0;
        cur_e = fw[0]; nxt_e = fw[1];
        __syncthreads();
        if (cur_e >= 0) {
            att::BlockRef<att::bf16, att::bf16> cur = att_ref(p, cur_e);
            att::Seam<att::bf16> S;
            att::causal_swa_prime<att::bf16, att::bf16>(cur, SEQ, (char*)lds, S, wave);
            for (;;) {
                const bool last = nxt_e < 0;
                const att::BlockRef<att::bf16, att::bf16> nxt = last ? cur : att_ref(p, nxt_e);
                int fetched = -1;
                if (!last) { FRESH(); if (tid == 0) fetched = att_fetch(p); }
                att::causal_swa_block<att::bf16, att::bf16>(cur, nxt, SEQ, SEQ, (char*)lds, S, wave);
                if (last) break;
                { FRESH(); if (tid == 0) fw[0] = fetched; }
                __syncthreads();
                cur = nxt; nxt_e = fw[0];
                __syncthreads();
            }
        }
        asm volatile("s_waitcnt vmcnt(0)" ::: "memory");
        __syncthreads();
        { FRESH(); lru_phase<true>(p, L3, lane, wave); }
    }
    GRID_BAR();
    for (int rep = 0; rep < DUP_P4; ++rep)
    { pg8::StaticOrder S; S.init(NTOK, DM, G, bid);
      pg8::Gemm g{PL0 + PE, (const bf16_t*)(dob + DO_WA), NTOK, DM, 2 * DM, (const bf16_t*)(p.ws + WS_UB), (const bf16_t*)(dob + DO_WB)};
      pg8::EpiMix E{PL0 + 5 * PE, PL0 + 6 * PE, PL0 + 2 * PE};
      pg8::gemm_phase<pg8::EpiMix, pg8::StaticOrder, true, true, true>(L3, g, S, E, wave); }
    GRID_BAR();
    { FRESH();
      if (bid == 0) { unsigned* b2 = (unsigned*)(p.ws + WS_UB + UB_BAR2); for (int i = tid; i < BAR_BYTES / 4; i += 512) b2[i] = 0u; }
      { unsigned* z = (unsigned*)(p.ws + WS_UB + UB_SSQ2); for (int i = bid * 512 + tid; i < (int)((UB_WDN - UB_SSQ2) / 4); i += G * 512) z[i] = 0u; }
      LAS float* scr = (LAS float*)(L3 + wave * 16384);
      for (int it = bid * 8 + wave; it < 64 * 32; it += G * 8) tr_item(p.in[16], 1024, 32, 4096, (bf16_t*)(p.ws + WS_UB + UB_WDN), nullptr, scr, it, lane);
      __syncthreads(); }
    { pg8::StaticOrder S; S.init(NTOK, DM, G, bid);
      pg8::Gemm g{PL0 + 2 * PE, (const bf16_t*)(dob + DO_WO), NTOK, DM, DM, nullptr, nullptr}; pg8::EpiRes1 E{p.in[0], PL0, (float*)(dob + DO_SSQ)};
      pg8::gemm_phase<pg8::EpiRes1, pg8::StaticOrder, true, true>(L3, g, S, E, wave); }
    GRID_BAR();
    const XcdBarrier xbar2 = xcd_barrier_post((unsigned*)(p.ws + WS_UB + UB_BAR2), MISC + 2, wave);
    for (int rep = 0; rep < DUP_P6; ++rep)
    { pg8::StaticOrder S; S.init(NTOK, DFF, G, bid);
      pg8::Gemm g{PL0, (const bf16_t*)(dob + DO_WUP), NTOK, DFF, DM, nullptr, nullptr}; pg8::EpiUp E{(const float*)(dob + DO_SSQ), PL0 + PE};
      pg8::gemm_phase<pg8::EpiUp, pg8::StaticOrder, true, true>(L3, g, S, E, wave); }
    xcd_barrier(xbar2, wave);
    { pg8::StaticOrder S; S.init(NTOK, DM, G, bid);
      pg8::Gemm g{PL0 + PE, (const bf16_t*)(p.ws + WS_UB + UB_WDN), NTOK, DM, DFF, nullptr, nullptr};
      pg8::EpiDownNorm E{PL0, p.out, p.in[17], (float*)(p.ws + WS_UB + UB_SSQ2), (unsigned*)(p.ws + WS_UB + UB_CNT)};
      pg8::gemm_phase<pg8::EpiDownNorm, pg8::StaticOrder, true, true>(L3, g, S, E, wave); }
}

extern "C" void kernel_launch(void* const* d_in, const int* in_sizes, int n_in, void* d_out, int out_size, void* d_ws, size_t ws_size, hipStream_t stream) {
    static int grid = 0;
    if (grid == 0) {
        if (n_in != 18 || in_sizes[0] != NTOK * DM || out_size != NTOK * DM || ws_size < WS_NEED) {
            fprintf(stderr, "kernel_launch: unexpected shapes (n_in %d, in0 %d, out %d, ws %zu)\n", n_in, n_in > 0 ? in_sizes[0] : -1, out_size, ws_size); grid = -1; return; }
        int dev = 0, cus = 0, per_cu = 0;
        (void)hipGetDevice(&dev); (void)hipDeviceGetAttribute(&cus, hipDeviceAttributeMultiprocessorCount, dev);
        if (hipFuncSetAttribute((const void*)mega_fwd, hipFuncAttributeMaxDynamicSharedMemorySize, LDS_BYTES) != hipSuccess) { fprintf(stderr, "kernel_launch: hipFuncSetAttribute failed\n"); grid = -1; return; }
        if (hipOccupancyMaxActiveBlocksPerMultiprocessor(&per_cu, (const void*)mega_fwd, 512, LDS_BYTES) != hipSuccess || per_cu < 1) { fprintf(stderr, "kernel_launch: occupancy query says %d\n", per_cu); per_cu = 1; }
        (void)hipGetLastError();
        grid = cus > 0 ? cus : 256;
    }
    if (grid < 0) return;
    if (hipMemsetAsync((unsigned char*)d_out + DO_BAR, 0, BAR_BYTES, stream) != hipSuccess) { fprintf(stderr, "kernel_launch: memset failed\n"); return; }
    Params p{};
    for (int i = 0; i < 18; ++i) p.in[i] = (const float*)d_in[i];
    p.out = (float*)d_out; p.ws = (unsigned char*)d_ws;
    void* args[] = {&p};
    hipError_t e = hipLaunchCooperativeKernel((const void*)mega_fwd, dim3(grid), dim3(512), args, LDS_BYTES, stream);
    if (e != hipSuccess) fprintf(stderr, "cooperative launch failed: %s (grid %d)\n", hipGetErrorString(e), grid);
}
```
